# Optimizing an MI355X kernel written in HIP

```python
import math
import jax, jax.numpy as jnp
from jax import lax
import numpy as np

D_MODEL = 1024
BATCH = 8
SEQ = 4096
DEPTH = 1

D_FF = 2816
A_WIDTH = 512
A_GROUPS = 8
A_GROUP_DIM = A_WIDTH // A_GROUPS
CHUNK = 128
B_HEADS = 8
B_QK_DIM = 64
B_V_DIM = 2 * B_QK_DIM
B_WIDTH = B_HEADS * B_V_DIM
ROPE_THETA = 500000.0
ROT_DIM = B_QK_DIM // 4
Q_BLOCK = 128
NORM_EPS = 1e-6
LN_EPS = 1e-5
COL_SIZES = (D_MODEL, D_MODEL, 2 * A_WIDTH,
             B_HEADS * 2 * B_QK_DIM, B_HEADS * 2 * B_QK_DIM, B_WIDTH)
IN_COLS = sum(COL_SIZES)
COL_SPLITS = tuple(int(c) for c in np.cumsum(COL_SIZES)[:-1])

kernel_name = 'hybrid_gmlp_diffattn_macaron'


def rms_norm(x, gain, eps=NORM_EPS):
    xf = x.astype(jnp.float32)
    y = xf * lax.rsqrt(jnp.mean(xf * xf, axis=-1, keepdims=True) + eps)
    return (y * gain.astype(jnp.float32)).astype(x.dtype)


def layer_norm(x, gain, bias, eps=LN_EPS):
    xf = x.astype(jnp.float32)
    mu = jnp.mean(xf, axis=-1, keepdims=True)
    xc = xf - mu
    y = xc * lax.rsqrt(jnp.mean(xc * xc, axis=-1, keepdims=True) + eps)
    return (y * gain.astype(jnp.float32) + bias.astype(jnp.float32)).astype(x.dtype)


def swiglu(h, w_gate, w_up, w_down):
    return (jax.nn.silu(h @ w_gate) * (h @ w_up)) @ w_down


def rope_tables(positions):
    inv = ROPE_THETA ** (-jnp.arange(0, ROT_DIM, 2, dtype=jnp.float32) / ROT_DIM)
    ang = positions.astype(jnp.float32)[..., None] * inv
    return jnp.cos(ang), jnp.sin(ang)


def apply_partial_rope(t, cos, sin):
    half = ROT_DIM // 2
    r1, r2, rest = t[..., :half], t[..., half:ROT_DIM], t[..., ROT_DIM:]
    return jnp.concatenate([r1 * cos - r2 * sin, r2 * cos + r1 * sin, rest], axis=-1)


def gmlp_chunk_mixer(z_uv, ln_g, ln_b, w_s, b_s):
    bsz, seq, _ = z_uv.shape
    z = jax.nn.gelu(z_uv, approximate=False)
    u, v = jnp.split(z, 2, axis=-1)
    v = layer_norm(v, ln_g, ln_b)
    vc = v.reshape(bsz, seq // CHUNK, CHUNK, A_GROUPS, A_GROUP_DIM)
    causal = jnp.tril(jnp.ones((CHUNK, CHUNK), dtype=bool))
    w = jnp.where(causal[None], w_s, jnp.zeros_like(w_s))
    f = jnp.einsum('gts,bcsge->bctge', w, vc) + b_s.T[:, :, None]
    return u * f.reshape(bsz, seq, A_WIDTH)


def diff_attention(q, k, v, positions, q_gain, k_gain, lq1, lk1, lq2, lk2, subln_g, lam_init):
    bsz, seq = q.shape[0], q.shape[1]
    out_dtype = v.dtype
    cos, sin = rope_tables(positions)
    cos, sin = cos[:, :, None, None, :], sin[:, :, None, None, :]
    qf = apply_partial_rope(rms_norm(q.astype(jnp.float32), q_gain), cos, sin)
    kf = apply_partial_rope(rms_norm(k.astype(jnp.float32), k_gain), cos, sin)
    qf = qf * (B_QK_DIM ** -0.5)
    qf = qf.transpose(0, 2, 3, 1, 4)
    kf = kf.transpose(0, 2, 3, 1, 4)
    vf = v.astype(jnp.float32).transpose(0, 2, 1, 3)
    lam = (jnp.exp(jnp.sum(lq1.astype(jnp.float32) * lk1.astype(jnp.float32)))
           - jnp.exp(jnp.sum(lq2.astype(jnp.float32) * lk2.astype(jnp.float32)))
           + lam_init)
    kpos = jnp.arange(seq)

    def block(i):
        start = i * Q_BLOCK
        qb = lax.dynamic_slice_in_dim(qf, start, Q_BLOCK, axis=3)
        s = jnp.einsum('bhmqd,bhmkd->bhmqk', qb, kf)
        qpos = start + jnp.arange(Q_BLOCK)
        mask = kpos[None, :] <= qpos[:, None]
        p = jax.nn.softmax(jnp.where(mask, s, -jnp.inf), axis=-1)
        a = p[:, :, 0] - lam * p[:, :, 1]
        return jnp.einsum('bhqk,bhkd->bhqd', a, vf)

    o = lax.map(block, jnp.arange(seq // Q_BLOCK))
    o = o.transpose(1, 0, 3, 2, 4).reshape(bsz, seq, B_HEADS, B_V_DIM)
    o = rms_norm(o, subln_g) * (1.0 - lam_init)
    return o.reshape(bsz, seq, B_WIDTH).astype(out_dtype)


def setup_inputs(seed: int = 0) -> dict:
    key = jax.random.key(seed)
    ks = jax.random.split(key, 32)
    f32 = jnp.float32
    L = DEPTH

    def nrm(k, shape, scale):
        return jax.random.normal(k, shape, dtype=f32) * scale

    def gain(k, shape):
        return 1.0 + 0.01 * jax.random.normal(k, shape, dtype=f32)

    return {
        'x': jax.random.normal(ks[0], (BATCH, SEQ, D_MODEL), dtype=f32),
        'positions': jnp.broadcast_to(jnp.arange(SEQ, dtype=jnp.int32), (BATCH, SEQ)),
        'ffn1_norm': gain(ks[1], (L, D_MODEL)),
        'ffn1_w_gate': nrm(ks[2], (L, D_MODEL, D_FF), D_MODEL ** -0.5),
        'ffn1_w_up': nrm(ks[3], (L, D_MODEL, D_FF), D_MODEL ** -0.5),
        'ffn1_w_down': nrm(ks[4], (L, D_FF, D_MODEL), D_FF ** -0.5),
        'mix_norm': gain(ks[5], (L, D_MODEL)),
        'w_in': nrm(ks[6], (L, D_MODEL, IN_COLS), D_MODEL ** -0.5),
        'a_ln_gain': gain(ks[7], (L, A_WIDTH)),
        'a_ln_bias': nrm(ks[8], (L, A_WIDTH), 0.01),
        'a_w_s': nrm(ks[9], (L, A_GROUPS, CHUNK, CHUNK), 0.5 * CHUNK ** -0.5),
        'a_b_s': gain(ks[10], (L, A_GROUPS, CHUNK)),
        'a_w_proj': nrm(ks[11], (L, A_WIDTH, D_MODEL), A_WIDTH ** -0.5),
        'b_q_norm': gain(ks[12], (L, B_QK_DIM)),
        'b_k_norm': gain(ks[13], (L, B_QK_DIM)),
        'b_lambda_q1': nrm(ks[14], (L, B_QK_DIM), 0.1),
        'b_lambda_k1': nrm(ks[15], (L, B_QK_DIM), 0.1),
        'b_lambda_q2': nrm(ks[16], (L, B_QK_DIM), 0.1),
        'b_lambda_k2': nrm(ks[17], (L, B_QK_DIM), 0.1),
        'b_subln': gain(ks[18], (L, B_V_DIM)),
        'b_w_proj': nrm(ks[19], (L, B_WIDTH, D_MODEL), B_WIDTH ** -0.5),
        'w_out': nrm(ks[20], (L, D_MODEL, D_MODEL), D_MODEL ** -0.5),
        'ffn2_norm': gain(ks[21], (L, D_MODEL)),
        'ffn2_w_gate': nrm(ks[22], (L, D_MODEL, D_FF), D_MODEL ** -0.5),
        'ffn2_w_up': nrm(ks[23], (L, D_MODEL, D_FF), D_MODEL ** -0.5),
        'ffn2_w_down': nrm(ks[24], (L, D_FF, D_MODEL), D_FF ** -0.5),
    }


def reference(x, positions, ffn1_norm, ffn1_w_gate, ffn1_w_up, ffn1_w_down, mix_norm, w_in,
              a_ln_gain, a_ln_bias, a_w_s, a_b_s, a_w_proj, b_q_norm, b_k_norm,
              b_lambda_q1, b_lambda_k1, b_lambda_q2, b_lambda_k2, b_subln, b_w_proj, w_out,
              ffn2_norm, ffn2_w_gate, ffn2_w_up, ffn2_w_down):
    bsz, seq, _ = x.shape
    for l in range(DEPTH):
        lam_init = 0.8 - 0.6 * math.exp(-0.3 * l)
        x = x + 0.5 * swiglu(rms_norm(x, ffn1_norm[l]), ffn1_w_gate[l], ffn1_w_up[l], ffn1_w_down[l])
        h = rms_norm(x, mix_norm[l])
        z = h @ w_in[l]
        g_a, g_b, z_uv, z_q, z_k, z_v = jnp.split(z, COL_SPLITS, axis=-1)
        y_a = gmlp_chunk_mixer(z_uv, a_ln_gain[l], a_ln_bias[l], a_w_s[l], a_b_s[l])
        q = z_q.reshape(bsz, seq, B_HEADS, 2, B_QK_DIM)
        k = z_k.reshape(bsz, seq, B_HEADS, 2, B_QK_DIM)
        v = z_v.reshape(bsz, seq, B_HEADS, B_V_DIM)
        y_b = diff_attention(q, k, v, positions, b_q_norm[l], b_k_norm[l],
                             b_lambda_q1[l], b_lambda_k1[l], b_lambda_q2[l], b_lambda_k2[l],
                             b_subln[l], lam_init)
        m = jax.nn.sigmoid(g_a) * (y_a @ a_w_proj[l]) + jax.nn.sigmoid(g_b) * (y_b @ b_w_proj[l])
        x = x + m @ w_out[l]
        x = x + 0.5 * swiglu(rms_norm(x, ffn2_norm[l]), ffn2_w_gate[l], ffn2_w_up[l], ffn2_w_down[l])
    return x
```

```cpp
#include <hip/hip_runtime.h>
#include <hip/hip_cooperative_groups.h>
#include <cstdio>
#include <cstdint>
namespace cg = cooperative_groups;
namespace pg8 {
#define PG8_LAS __attribute__((address_space(3)))
typedef unsigned short bf16_t;
typedef short bf16x8 __attribute__((ext_vector_type(8)));
typedef float f32x4 __attribute__((ext_vector_type(4)));
typedef unsigned u32x4 __attribute__((ext_vector_type(4)));
constexpr int BM = 256, BK = 64, HALF = 128, HTB = HALF * BK * 2  , STAGE_BYTES = 8 * HTB, NXCD = 8, WGM = 8;

__host__ __device__ __forceinline__ int lds_byte(int r, int c) { const int st = (r >> 4) * 2 + (c >> 5), rr = r & 15, cc = c & 31, ob = rr * 64 + cc * 2; return st * 1024 + (ob ^ (((ob >> 9) & 1) << 5)); }
__host__ __device__ __forceinline__ void stage_rc(int b, int& R, int& C) { const int st = b / 1024, sb = b % 1024, swz = sb ^ (((sb >> 9) & 1) << 5); R = (st >> 1) * 16 + swz / 64; C = (st & 1) * 32 + (swz % 64) / 2; }
__host__ __device__ __forceinline__ int perm32(int rho) { const int n = rho >> 4, i = rho & 15; return 8 * (i >> 2) + 4 * n + (i & 3); }

struct Unit { int pm, pn; };
struct Gemm { const bf16_t* A; const bf16_t* Bt; int M, N, K; };

struct StaticOrder {
    int nM, nN, nwg, G, c;
    __host__ __device__ void init(int M, int N, int G_, int c_) { nM = M / BM; nN = N / BM; nwg = nM * nN; G = G_; c = c_; }
    __host__ __device__ bool next(int i, Unit& u) const {
        const long L = (long)i * G + c; if (L >= nwg) return false;
        int wgid = (int)L; { const int q = nwg / NXCD, r = nwg % NXCD, xcd = wgid % NXCD, off = wgid / NXCD; wgid = (xcd < r ? xcd * (q + 1) : r * (q + 1) + (xcd - r) * q) + off; }
        const int nig = WGM * nN, gid = wgid / nig, fm = gid * WGM, gsz = (nM - fm) < WGM ? (nM - fm) : WGM;
        u.pm = fm + ((wgid % nig) % gsz); u.pn = (wgid % nig) / gsz; return true;
    }
    __device__ __forceinline__ void a_ready(const Unit&) const {}
    __device__ __forceinline__ void done(const Unit&) const {}
};

__device__ __forceinline__ unsigned cvt_pk_bf16(float lo, float hi) { unsigned r; asm volatile("v_cvt_pk_bf16_f32 %0, %1, %2" : "=v"(r) : "v"(lo), "v"(hi)); return r; }
typedef float f32x2 __attribute__((ext_vector_type(2)));
__device__ __forceinline__ f32x2 gelu_pk(f32x2 v) {
    const f32x2 av = __builtin_elementwise_abs(v), d = av * 0.2316418882f + 1.0f;
    f32x2 t; t.x = __builtin_amdgcn_rcpf(d.x); t.y = __builtin_amdgcn_rcpf(d.y);
    f32x2 q = t * 0.5307027145f + (-0.7265760135f); q = q * t + 0.7107068705f; q = q * t + (-0.142248368f); q = q * t + 0.127414796f; q = q * t;
    const f32x2 s = (v * v) * (-0.72134752044f);
    f32x2 e; e.x = __builtin_amdgcn_exp2f(s.x); e.y = __builtin_amdgcn_exp2f(s.y);
    const f32x2 m = v * (q * e), r = v - m;
    f32x2 o; o.x = v.x < 0.f ? m.x : r.x; o.y = v.y < 0.f ? m.y : r.y; return o;
}
__device__ __forceinline__ f32x4 gelu4(f32x4 v) { f32x2 a = gelu_pk((f32x2){v[0], v[1]}), b = gelu_pk((f32x2){v[2], v[3]}); return (f32x4){a.x, a.y, b.x, b.y}; }
__device__ __forceinline__ float sigm1(float x) { return __builtin_amdgcn_rcpf(1.0f + __builtin_amdgcn_exp2f(-1.4426950408889634f * x)); }
__device__ __forceinline__ f32x4 sigm4(f32x4 v) { return (f32x4){sigm1(v[0]), sigm1(v[1]), sigm1(v[2]), sigm1(v[3])}; }
__device__ __forceinline__ u32x4 pack8(f32x4 a, f32x4 b) { u32x4 w; w.x = cvt_pk_bf16(a[0], a[1]); w.y = cvt_pk_bf16(a[2], a[3]); w.z = cvt_pk_bf16(b[0], b[1]); w.w = cvt_pk_bf16(b[2], b[3]); return w; }
__device__ __forceinline__ void unpack8(u32x4 w, f32x4& a, f32x4& b) {
    a = (f32x4){__uint_as_float(w.x << 16), __uint_as_float(w.x & 0xffff0000u), __uint_as_float(w.y << 16), __uint_as_float(w.y & 0xffff0000u)};
    b = (f32x4){__uint_as_float(w.z << 16), __uint_as_float(w.z & 0xffff0000u), __uint_as_float(w.w << 16), __uint_as_float(w.w & 0xffff0000u)}; }
constexpr int SSN = 16;
__device__ __forceinline__ float row_rstd(const float* ss, int row) {
    const f32x4* p = (const f32x4*)(ss + (size_t)row * SSN); const f32x4 a = p[0], b = p[1], c = p[2], d = p[3];
    const f32x4 s = (a + b) + (c + d); const float t = (s[0] + s[1]) + (s[2] + s[3]);
    return __builtin_amdgcn_rsqf(t * (1.0f / 1024.0f) + 1e-6f);
}

__device__ __forceinline__ void rstd8(const float* ss, int row0, int fq, float (&rs)[2][4]) {
    f32x4 t[2][4];
#pragma unroll
    for (int ai = 0; ai < 2; ++ai)
#pragma unroll
        for (int m = 0; m < 4; ++m) t[ai][m] = *(const f32x4*)(ss + (size_t)(row0 + ai * HALF + m * 16) * SSN + 4 * fq);
#pragma unroll
    for (int ai = 0; ai < 2; ++ai)
#pragma unroll
        for (int m = 0; m < 4; ++m) { float v = (t[ai][m][0] + t[ai][m][1]) + (t[ai][m][2] + t[ai][m][3]); v += __shfl_xor(v, 16); v += __shfl_xor(v, 32);
            rs[ai][m] = __builtin_amdgcn_rsqf(v * (1.0f / 1024.0f) + 1e-6f); }
}
typedef PG8_LAS float* rs_tab_t;
constexpr int RS_TAB_OFF = 131072 + 1024, RS_TAG_OFF = 131072 + 1024 + 4096;
__device__ __forceinline__ void rs_tags_clear(PG8_LAS unsigned char* lds) { if (threadIdx.x < 8) ((PG8_LAS int*)(lds + RS_TAG_OFF))[threadIdx.x] = -1; asm volatile("s_waitcnt lgkmcnt(0)" ::: "memory"); __builtin_amdgcn_s_barrier(); }
__device__ __forceinline__ void rs_cached(PG8_LAS unsigned char* lds, const float* ss, const Unit& u, int wr, int wc, int fr, int fq, float (&rs)[2][4]) {
    const int wid = wr * 4 + wc; rs_tab_t tab = (rs_tab_t)(lds + RS_TAB_OFF) + wid * 128; PG8_LAS int* tagp = (PG8_LAS int*)(lds + RS_TAG_OFF) + wid;
    const int tag = __builtin_amdgcn_readfirstlane(*tagp);
    if (tag != u.pm) {
        rstd8(ss, u.pm * BM + wr * 64 + fr, fq, rs);
        if (fq == 0) {
#pragma unroll
            for (int ai = 0; ai < 2; ++ai)
#pragma unroll
                for (int m = 0; m < 4; ++m) tab[ai * 64 + m * 16 + fr] = rs[ai][m];
        }
        if (fr == 0 && fq == 0) *tagp = u.pm;
    } else {
#pragma unroll
        for (int ai = 0; ai < 2; ++ai)
#pragma unroll
            for (int m = 0; m < 4; ++m) rs[ai][m] = tab[ai * 64 + m * 16 + fr];
    }
}
struct EpiSwiglu {
    static constexpr bool PERM = true, AFTER_DRAIN = false;
    bf16_t* H; const float* ss; int ldh; PG8_LAS unsigned char* lds;
    __device__ __forceinline__ void operator()(const f32x4 (&acc)[2][2][4][2], const Unit& u, int wr, int wc, int fr, int fq) const {
        const int row0 = u.pm * BM + wr * 64 + fr, col0 = u.pn * HALF + wc * 32 + 8 * fq;
        float rsv[2][4]; rs_cached(lds, ss, u, wr, wc, fr, fq, rsv);
#pragma unroll
        for (int ai = 0; ai < 2; ++ai)
#pragma unroll
            for (int m = 0; m < 4; ++m) { const int row = row0 + ai * HALF + m * 16; const float rs = rsv[ai][m]; const float c1 = -1.4426950408889634f * rs, c2 = rs * rs;
                f32x4 o[2];
#pragma unroll
                for (int n = 0; n < 2; ++n) {
                    const f32x4 ga = acc[ai][0][m][n], t = ga * c1; f32x4 sg;
#pragma unroll
                    for (int i = 0; i < 4; ++i) sg[i] = __builtin_amdgcn_rcpf(1.0f + __builtin_amdgcn_exp2f(t[i]));
                    o[n] = (ga * acc[ai][1][m][n]) * (sg * c2); }
                *(u32x4*)(H + (size_t)row * ldh + col0) = pack8(o[0], o[1]); }
    }
};
template <bool WX> struct EpiResid {
    static constexpr bool PERM = true, AFTER_DRAIN = false;
    const float* base; float* out; bf16_t* XB; float* ss; float scale;
    __device__ __forceinline__ void operator()(const f32x4 (&acc)[2][2][4][2], const Unit& u, int wr, int wc, int fr, int fq) const {
        const int row0 = u.pm * BM + wr * 64 + fr, col0 = u.pn * BM + wc * 32 + 8 * fq;
#pragma unroll
        for (int ai = 0; ai < 2; ++ai) {
            f32x4 bv[4][2][2];
#pragma unroll
            for (int m = 0; m < 4; ++m)
#pragma unroll
                for (int bj = 0; bj < 2; ++bj) { const size_t off = (size_t)(row0 + ai * HALF + m * 16) * 1024 + col0 + bj * HALF; bv[m][bj][0] = *(const f32x4*)(base + off); bv[m][bj][1] = *(const f32x4*)(base + off + 4); }
#pragma unroll
            for (int m = 0; m < 4; ++m) { const int row = row0 + ai * HALF + m * 16; float sq = 0.f;
#pragma unroll
                for (int bj = 0; bj < 2; ++bj) { const size_t off = (size_t)row * 1024 + col0 + bj * HALF;
                    const f32x4 b0 = bv[m][bj][0], b1 = bv[m][bj][1];
                    const f32x4 o0 = b0 + acc[ai][bj][m][0] * scale, o1 = b1 + acc[ai][bj][m][1] * scale;
                    __builtin_nontemporal_store(o0, (f32x4*)(out + off)); __builtin_nontemporal_store(o1, (f32x4*)(out + off + 4));
                    if (WX) { *(u32x4*)(XB + off) = pack8(o0, o1);
                        sq += (o0[0] * o0[0] + o0[1] * o0[1]) + (o0[2] * o0[2] + o0[3] * o0[3]) + (o1[0] * o1[0] + o1[1] * o1[1]) + (o1[2] * o1[2] + o1[3] * o1[3]); } }
                if (WX) { sq += __shfl_xor(sq, 16); sq += __shfl_xor(sq, 32); if (fq == 0) ss[(size_t)row * SSN + u.pn * 4 + wc] = sq; } } }
    }
};
template <bool FIRST> struct EpiGate {
    static constexpr bool PERM = true, AFTER_DRAIN = false;
    const bf16_t* SG; int sgoff; bf16_t* MM;
    __device__ __forceinline__ void operator()(const f32x4 (&acc)[2][2][4][2], const Unit& u, int wr, int wc, int fr, int fq) const {
        const int row0 = u.pm * BM + wr * 64 + fr, col0 = u.pn * BM + wc * 32 + 8 * fq;
#pragma unroll
        for (int ai = 0; ai < 2; ++ai) {
            u32x4 sgv[4][2], mmv[4][2];
#pragma unroll
            for (int m = 0; m < 4; ++m)
#pragma unroll
                for (int bj = 0; bj < 2; ++bj) { const int row = row0 + ai * HALF + m * 16, col = col0 + bj * HALF; sgv[m][bj] = *(const u32x4*)(SG + (size_t)row * 2048 + sgoff + col);
                    if (!FIRST) mmv[m][bj] = *(const u32x4*)(MM + (size_t)row * 1024 + col); }
#pragma unroll
            for (int m = 0; m < 4; ++m) { const int row = row0 + ai * HALF + m * 16;
#pragma unroll
                for (int bj = 0; bj < 2; ++bj) { const int col = col0 + bj * HALF;
                    f32x4 s0, s1; unpack8(sgv[m][bj], s0, s1);
                    f32x4 o0 = s0 * acc[ai][bj][m][0], o1 = s1 * acc[ai][bj][m][1];
                    bf16_t* mp = MM + (size_t)row * 1024 + col;
                    if (!FIRST) { f32x4 p0, p1; unpack8(mmv[m][bj], p0, p1); o0 += p0; o1 += p1; }
                    *(u32x4*)mp = pack8(o0, o1); } } }
    }
};
struct EpiWin {
    static constexpr bool PERM = true, AFTER_DRAIN = false;
    const float* ss; bf16_t *SG, *UV, *QB, *KB, *VB; const float* rope; const float *qg, *kg; float qscale; PG8_LAS unsigned char* lds;
    __device__ __forceinline__ void operator()(const f32x4 (&acc)[2][2][4][2], const Unit& u, int wr, int wc, int fr, int fq) const {
        const int row0 = u.pm * BM + wr * 64 + fr; const int typ = u.pn >> 2;
        float rsv[2][4]; rs_cached(lds, ss, u, wr, wc, fr, fq, rsv);
        if (typ == 3 || typ == 4) {
            const float* gp = (typ == 3) ? qg : kg; bf16_t* dst = (typ == 3) ? QB : KB; const float osc = (typ == 3) ? qscale : 1.0f;
            const int grp = 4 * (u.pn & 3) + wc;
            f32x4 gn[2][2];
            gn[0][0] = *(const f32x4*)(gp + (fq < 2 ? 4 * fq : 8 * fq)); gn[0][1] = *(const f32x4*)(gp + (fq < 2 ? 8 + 4 * fq : 8 * fq + 4));
            gn[1][0] = *(const f32x4*)(gp + 32 + 8 * fq); gn[1][1] = *(const f32x4*)(gp + 32 + 8 * fq + 4);
#pragma unroll
            for (int bj = 0; bj < 2; ++bj)
#pragma unroll
                for (int n = 0; n < 2; ++n) gn[bj][n] = gn[bj][n] * osc;
#pragma unroll
            for (int ai = 0; ai < 4; ++ai) {
                f32x4 csv[2], snv[2];
#pragma unroll
                for (int m = 0; m < 2; ++m) { const float* rp = rope + (size_t)(row0 + (ai >> 1) * HALF + ((ai & 1) * 2 + m) * 16) * 16 + 4 * (fq & 1); csv[m] = *(const f32x4*)rp; snv[m] = *(const f32x4*)(rp + 8); }
#pragma unroll
                for (int m = 0; m < 2; ++m) { const int AI = ai >> 1, M = (ai & 1) * 2 + m; const int row = row0 + AI * HALF + M * 16;
                    f32x4 v[2][2]; float sq = 0.f;
#pragma unroll
                    for (int bj = 0; bj < 2; ++bj)
#pragma unroll
                        for (int n = 0; n < 2; ++n) { v[bj][n] = acc[AI][bj][M][n]; const f32x4 x = v[bj][n]; sq += (x[0] * x[0] + x[1] * x[1]) + (x[2] * x[2] + x[3] * x[3]); }
                    sq += __shfl_xor(sq, 16); sq += __shfl_xor(sq, 32);
                    const float rs = rsv[AI][M]; const float rn = rs * __builtin_amdgcn_rsqf(rs * rs * sq * (1.0f / 64.0f) + 1e-6f);
                    const f32x4 cs = csv[m], sn = snv[m];
                    f32x4 r1 = v[0][0] * rn * gn[0][0], r2 = v[0][1] * rn * gn[0][1];
                    if (fq < 2) { const f32x4 a = r1 * cs - r2 * sn, b = r2 * cs + r1 * sn; r1 = a; r2 = b; }
                    const f32x4 t0 = v[1][0] * rn * gn[1][0], t1 = v[1][1] * rn * gn[1][1];
                    bf16_t* dp = dst + (size_t)row * 1024 + grp * 64 + 8 * fq;
                    *(u32x4*)dp = pack8(r1, r2); *(u32x4*)(dp + 32) = pack8(t0, t1); } }
            return;
        }
        bf16_t* dst; int ldc, colt;
        if (typ < 2) { dst = SG; ldc = 2048; colt = u.pn * BM; } else if (typ == 2) { dst = UV; ldc = 1024; colt = (u.pn - 8) * BM; } else { dst = VB; ldc = 1024; colt = (u.pn - 20) * BM; }
        const int col0 = colt + wc * 32 + 8 * fq;
#pragma unroll
        for (int ai = 0; ai < 2; ++ai)
#pragma unroll
            for (int m = 0; m < 4; ++m) { const int row = row0 + ai * HALF + m * 16; const float rs = rsv[ai][m];
#pragma unroll
                for (int bj = 0; bj < 2; ++bj) { f32x4 v0, v1;
                    if (typ < 2) { const float c1 = -1.4426950408889634f * rs; const f32x4 t0 = acc[ai][bj][m][0] * c1, t1 = acc[ai][bj][m][1] * c1;
#pragma unroll
                        for (int i = 0; i < 4; ++i) { v0[i] = __builtin_amdgcn_rcpf(1.0f + __builtin_amdgcn_exp2f(t0[i])); v1[i] = __builtin_amdgcn_rcpf(1.0f + __builtin_amdgcn_exp2f(t1[i])); } }
                    else { v0 = acc[ai][bj][m][0] * rs; v1 = acc[ai][bj][m][1] * rs; if (typ == 2) { v0 = gelu4(v0); v1 = gelu4(v1); } }
                    if (typ < 2) __builtin_nontemporal_store(pack8(v0, v1), (u32x4*)(dst + (size_t)row * ldc + col0 + bj * HALF)); else *(u32x4*)(dst + (size_t)row * ldc + col0 + bj * HALF) = pack8(v0, v1); } }
    }
};
struct EpiPlainH {
    static constexpr bool PERM = true, AFTER_DRAIN = false;
    bf16_t* H; int ldh;
    __device__ __forceinline__ void operator()(const f32x4 (&acc)[2][2][4][2], const Unit& u, int wr, int wc, int fr, int fq) const {
        const int row0 = u.pm * BM + wr * 64 + fr, col0 = u.pn * HALF + wc * 32 + 8 * fq;
#pragma unroll
        for (int ai = 0; ai < 2; ++ai)
#pragma unroll
            for (int m = 0; m < 4; ++m) { const int row = row0 + ai * HALF + m * 16;
                *(u32x4*)(H + (size_t)row * ldh + col0) = pack8(acc[ai][0][m][0] + acc[ai][1][m][0], acc[ai][0][m][1] + acc[ai][1][m][1]); }
    }
};
template <class Epi, class Sched, bool ALIGN_EPI = false, bool SP2 = false>
__device__ __forceinline__ void gemm_phase(PG8_LAS unsigned char* lds, const Gemm g, const Sched& S, const Epi& E) {
    int tid_ = threadIdx.x; asm volatile("" : "+v"(tid_));
    const int tid = tid_, wid = __builtin_amdgcn_readfirstlane(tid >> 6), lane = tid & 63, wr = wid >> 2, wc = wid & 3, fr = lane & 15, fq = lane >> 4;
    int K_ = g.K; asm volatile("" : "+s"(K_));
    const int K = K_, nt = K / BK;
    unsigned voffA[2], voffB[2];
#pragma unroll
    for (int i = 0; i < 2; ++i) { int R, C; stage_rc(tid * 16 + i * 8192, R, C); const int Rb = Epi::PERM ? ((R & ~31) + perm32(R & 31)) : R;
        voffA[i] = (unsigned)(R * K + C) * 2u; voffB[i] = (unsigned)(Rb * K + C) * 2u; }
    const size_t kstep = (size_t)(BK * 2);
    const size_t hstep = (size_t)HALF * K * 2;
    const size_t tstep = 2 * hstep;
    const unsigned ldsw = (unsigned)wid * 1024u;
    const int aoff = lds_byte(wr * 64 + fr, fq * 8), boff = lds_byte(wc * 32 + fr, fq * 8);
#define PG8_SA(b, h) (((b) * 2 + (h)) * HTB)
#define PG8_SB(b, h) ((4 + (b) * 2 + (h)) * HTB)
#define PG8_STAGE(bufoff, gbase, voff) do { _Pragma("unroll") for (int _i = 0; _i < 2; ++_i) \
        __builtin_amdgcn_global_load_lds((const unsigned*)((const char*)(gbase) + (voff)[_i]), (PG8_LAS unsigned*)(lds + (bufoff) + ldsw + _i * 8192), 16, 0, 0); } while (0)
#define PG8_LDA(dst, b, h) do { _Pragma("unroll") for (int m = 0; m < 4; ++m) _Pragma("unroll") for (int k = 0; k < 2; ++k) dst[m][k] = *(const PG8_LAS bf16x8*)(lds + PG8_SA(b, h) + aoff + m * 2048 + k * 1024); } while (0)
#define PG8_LDB(dst, b, h) do { _Pragma("unroll") for (int n = 0; n < 2; ++n) _Pragma("unroll") for (int k = 0; k < 2; ++k) dst[n][k] = *(const PG8_LAS bf16x8*)(lds + PG8_SB(b, h) + boff + n * 2048 + k * 1024); } while (0)
#define PG8_MMA(ai, bj, At, Bt) do { __builtin_amdgcn_s_setprio(1); _Pragma("unroll") for (int m = 0; m < 4; ++m) _Pragma("unroll") for (int n = 0; n < 2; ++n) _Pragma("unroll") for (int k = 0; k < 2; ++k) \
        acc[ai][bj][m][n] = __builtin_amdgcn_mfma_f32_16x16x32_bf16(Bt[n][k], At[m][k], acc[ai][bj][m][n], 0, 0, 0); __builtin_amdgcn_s_setprio(0); } while (0)
#define PG8_WAIT_V(n) asm volatile("s_waitcnt vmcnt(" #n ")" ::: "memory")
#define PG8_WAIT_L(n) asm volatile("s_waitcnt lgkmcnt(" #n ")" ::: "memory")
#define PG8_BAR __builtin_amdgcn_s_barrier()
#define PG8_SCHED __builtin_amdgcn_sched_barrier(0)
    Unit cur, nxt; int ui = 0;
    if (!S.next(0, cur)) return;
    f32x4 acc[2][2][4][2];
#pragma unroll
    for (int a = 0; a < 2; ++a)
#pragma unroll
        for (int b = 0; b < 2; ++b)
#pragma unroll
            for (int m = 0; m < 4; ++m)
#pragma unroll
                for (int n = 0; n < 2; ++n) acc[a][b][m][n] = (f32x4){0.f, 0.f, 0.f, 0.f};
    bf16x8 At[4][2], B0[2][2], B1[2][2];
    const char* cA = (const char*)g.A + (size_t)cur.pm * tstep; const char* cB = (const char*)g.Bt + (size_t)cur.pn * tstep;
    S.a_ready(cur);
    if constexpr (SP2) {
        PG8_STAGE(PG8_SB(0, 0), cB, voffB); PG8_STAGE(PG8_SB(0, 1), cB + hstep, voffB); PG8_STAGE(PG8_SA(0, 0), cA, voffA); PG8_STAGE(PG8_SA(0, 1), cA + hstep, voffA);
        if (wr == 1) PG8_BAR;
        PG8_WAIT_V(2); PG8_BAR;
        PG8_STAGE(PG8_SB(1, 0), cB + kstep, voffB); PG8_STAGE(PG8_SA(1, 0), cA + kstep, voffA); PG8_STAGE(PG8_SB(1, 1), cB + hstep + kstep, voffB);
        PG8_WAIT_V(6); PG8_BAR;
    } else {
        PG8_STAGE(PG8_SB(0, 0), cB, voffB); PG8_STAGE(PG8_SA(0, 0), cA, voffA); PG8_STAGE(PG8_SB(0, 1), cB + hstep, voffB); PG8_STAGE(PG8_SA(0, 1), cA + hstep, voffA);
        if (wr == 1) PG8_BAR;
        PG8_WAIT_V(4); PG8_BAR;
        PG8_STAGE(PG8_SB(1, 0), cB + kstep, voffB); PG8_STAGE(PG8_SA(1, 0), cA + kstep, voffA); PG8_STAGE(PG8_SB(1, 1), cB + hstep + kstep, voffB);
        PG8_WAIT_V(6); PG8_BAR;
    }
    for (;;) {
        const bool has_next = S.next(ui + 1, nxt);
        const char* nA = has_next ? (const char*)g.A + (size_t)nxt.pm * tstep : cA; const char* nB = has_next ? (const char*)g.Bt + (size_t)nxt.pn * tstep : cB;
        for (int t = 0; t < nt; t += 2) {
            const bool last = (t == nt - 2);
            const char* a1 = cA + (size_t)(t + 1) * kstep;
            const char* a2 = last ? nA : cA + (size_t)(t + 2) * kstep; const char* b2 = last ? nB : cB + (size_t)(t + 2) * kstep;
            const char* a3 = a2 + kstep; const char* b3 = b2 + kstep;
            if (last && has_next) S.a_ready(nxt);
            if constexpr (SP2) {
            PG8_LDB(B0, 0, 0); PG8_LDB(B1, 0, 1); PG8_SCHED; PG8_LDA(At, 0, 0); PG8_STAGE(PG8_SA(1, 1), a1 + hstep, voffA);
            PG8_WAIT_V(8); PG8_WAIT_L(0); PG8_BAR; PG8_MMA(0, 0, At, B0); PG8_MMA(0, 1, At, B1); PG8_BAR; PG8_SCHED;
            PG8_LDA(At, 0, 1); PG8_STAGE(PG8_SB(0, 0), b2, voffB); PG8_STAGE(PG8_SB(0, 1), b2 + hstep, voffB); PG8_STAGE(PG8_SA(0, 0), a2, voffA);
            PG8_WAIT_V(8); PG8_WAIT_L(0); PG8_BAR; PG8_MMA(1, 0, At, B0); PG8_MMA(1, 1, At, B1); PG8_BAR; PG8_SCHED;
            PG8_LDB(B0, 1, 0); PG8_LDB(B1, 1, 1); PG8_SCHED; PG8_LDA(At, 1, 0); PG8_STAGE(PG8_SA(0, 1), a2 + hstep, voffA);
            PG8_WAIT_V(8); PG8_WAIT_L(0); PG8_BAR; PG8_MMA(0, 0, At, B0); PG8_MMA(0, 1, At, B1); PG8_BAR; PG8_SCHED;
            PG8_LDA(At, 1, 1); PG8_STAGE(PG8_SB(1, 0), b3, voffB); PG8_STAGE(PG8_SB(1, 1), b3 + hstep, voffB); PG8_STAGE(PG8_SA(1, 0), a3, voffA);
            PG8_WAIT_V(8); PG8_WAIT_L(0); PG8_BAR; PG8_MMA(1, 0, At, B0); PG8_MMA(1, 1, At, B1); PG8_BAR; PG8_SCHED;
            } else {
            PG8_LDB(B0, 0, 0); PG8_SCHED; PG8_LDA(At, 0, 0); PG8_STAGE(PG8_SA(1, 1), a1 + hstep, voffA);
            PG8_WAIT_L(8); PG8_BAR; PG8_WAIT_L(0); PG8_MMA(0, 0, At, B0); PG8_BAR; PG8_SCHED;
            PG8_LDB(B1, 0, 1); PG8_STAGE(PG8_SB(0, 0), b2, voffB);
            PG8_BAR; PG8_WAIT_L(0); PG8_MMA(0, 1, At, B1); PG8_BAR;
            PG8_LDA(At, 0, 1); PG8_STAGE(PG8_SA(0, 0), a2, voffA);
            PG8_BAR; PG8_WAIT_L(0); PG8_MMA(1, 0, At, B0); PG8_BAR; PG8_SCHED;
            PG8_STAGE(PG8_SB(0, 1), b2 + hstep, voffB);
            PG8_WAIT_V(6); PG8_BAR; PG8_MMA(1, 1, At, B1); PG8_BAR;
            PG8_LDB(B0, 1, 0); PG8_SCHED; PG8_LDA(At, 1, 0); PG8_STAGE(PG8_SA(0, 1), a2 + hstep, voffA);
            PG8_WAIT_L(8); PG8_BAR; PG8_WAIT_L(0); PG8_MMA(0, 0, At, B0); PG8_BAR; PG8_SCHED;
            PG8_LDB(B1, 1, 1); PG8_STAGE(PG8_SB(1, 0), b3, voffB);
            PG8_BAR; PG8_WAIT_L(0); PG8_MMA(0, 1, At, B1); PG8_BAR;
            PG8_LDA(At, 1, 1); PG8_STAGE(PG8_SA(1, 0), a3, voffA);
            PG8_BAR; PG8_WAIT_L(0); PG8_MMA(1, 0, At, B0); PG8_BAR; PG8_SCHED;
            PG8_STAGE(PG8_SB(1, 1), b3 + hstep, voffB);
            PG8_WAIT_V(6); PG8_BAR; PG8_MMA(1, 1, At, B1); PG8_BAR;
            }
        }
        if constexpr (ALIGN_EPI) { if (wr == 0) PG8_BAR; }
        if constexpr (!Epi::AFTER_DRAIN) { E(acc, cur, wr, wc, fr, fq); S.done(cur); }
        if (!has_next) break;
#pragma unroll
        for (int a = 0; a < 2; ++a)
#pragma unroll
            for (int b = 0; b < 2; ++b)
#pragma unroll
                for (int m = 0; m < 4; ++m)
#pragma unroll
                    for (int n = 0; n < 2; ++n) acc[a][b][m][n] = (f32x4){0.f, 0.f, 0.f, 0.f};
        cur = nxt; cA = nA; cB = nB; ++ui;
        if constexpr (ALIGN_EPI) { if (wr == 1) PG8_BAR; }
    }
    PG8_WAIT_V(0);
    if constexpr (!ALIGN_EPI) { if (wr == 0) PG8_BAR; }
    PG8_BAR;
    if constexpr (Epi::AFTER_DRAIN) { E.fused(acc, cur, wr, wc, fr, fq, lds, wid, lane); S.done(cur); }
#undef PG8_SA
#undef PG8_SB
#undef PG8_STAGE
#undef PG8_LDA
#undef PG8_LDB
#undef PG8_MMA
#undef PG8_WAIT_V
#undef PG8_WAIT_L
#undef PG8_BAR
#undef PG8_SCHED
}
}

constexpr int BATCH = 8, SEQ = 4096, DM = 1024, DFF = 2816, AW = 512, NH = 8, INC = 6144;
constexpr int MT = BATCH * SEQ;
constexpr int NWAVES = 8;
constexpr float QSCALE = 0.125f * 1.4426950408889634f;
constexpr float LAM_INIT = 0.2f;

constexpr size_t MiB = 1u << 20;
constexpr size_t WS_W1GU = 0;
constexpr size_t WS_W1D  = WS_W1GU + (size_t)2 * DFF * DM * 2;
constexpr size_t WS_WIN  = WS_W1D + (size_t)DM * DFF * 2;
constexpr size_t WS_WPA  = WS_WIN + (size_t)INC * DM * 2;
constexpr size_t WS_WPB  = WS_WPA + (size_t)DM * AW * 2;
constexpr size_t WS_WO   = WS_WPB + (size_t)DM * DM * 2;
constexpr size_t WS_W2GU = WS_WO + (size_t)DM * DM * 2;
constexpr size_t WS_W2D  = WS_W2GU + (size_t)2 * DFF * DM * 2;
constexpr size_t WS_WSP  = WS_W2D + (size_t)DM * DFF * 2;
constexpr size_t WS_ROPE = WS_WSP + (size_t)8 * 128 * 128 * 2;
constexpr size_t WS_SS   = WS_ROPE + (size_t)MT * 16 * 4;
constexpr size_t WS_R0END = WS_SS + (size_t)MT * 16 * 4;
static_assert(WS_R0END <= 64 * MiB, "weights region");
constexpr size_t WS_CTL = 60 * MiB, CTL_ZERO_BYTES = 65536;
static_assert(WS_R0END <= WS_CTL, "ctl");
constexpr size_t WS_XB = 64 * MiB;
constexpr size_t WS_YA = WS_XB;
constexpr size_t WS_H  = 128 * MiB;
constexpr size_t WS_SG = 128 * MiB;
constexpr size_t WS_UV = 256 * MiB;
constexpr size_t WS_MM = WS_UV;
constexpr size_t WS_Q  = 320 * MiB;
constexpr size_t WS_YB = WS_Q;
constexpr size_t WS_K  = 384 * MiB;
constexpr size_t WS_V  = 448 * MiB;
constexpr size_t WS_END = 512 * MiB;
static_assert(WS_H + (size_t)MT * DFF * 2 <= WS_Q, "H overlay");

constexpr int LDS_BYTES = 147456;

#define LAS __attribute__((address_space(3)))
typedef unsigned short bf16;
typedef float f32x4 __attribute__((ext_vector_type(4)));
typedef float f32x16 __attribute__((ext_vector_type(16)));
typedef short bf16x8 __attribute__((ext_vector_type(8)));
typedef short s16x4 __attribute__((ext_vector_type(4)));
typedef unsigned u32x4 __attribute__((ext_vector_type(4)));
typedef unsigned u32x2 __attribute__((ext_vector_type(2)));
#define LDS_WAIT() asm volatile("s_waitcnt lgkmcnt(0)" ::: "memory")
#define MFMA32(a, b, c) __builtin_amdgcn_mfma_f32_32x32x16_bf16((a), (b), (c), 0, 0, 0)
__device__ __forceinline__ unsigned f2bf(float f) { unsigned u = __builtin_bit_cast(unsigned, f); return (u + 0x7fffu + ((u >> 16) & 1u)) >> 16; }
__device__ __forceinline__ unsigned pk2(float lo, float hi) { return f2bf(lo) | (f2bf(hi) << 16); }
__device__ __forceinline__ float bflo(unsigned w) { return __uint_as_float(w << 16); }
__device__ __forceinline__ float bfhi(unsigned w) { return __uint_as_float(w & 0xffff0000u); }
__device__ __forceinline__ float wave_sum(float v) {
#pragma unroll
    for (int o = 1; o < 64; o <<= 1) v += __shfl_xor(v, o);
    return v;
}
__device__ __forceinline__ int crow(int r, int hi) { return (r & 3) + 8 * (r >> 2) + 4 * hi; }
typedef short v4i16_t __attribute__((ext_vector_type(4)));
__device__ __forceinline__ s16x4 vtr(const LAS unsigned char* p) { return __builtin_bit_cast(s16x4, __builtin_amdgcn_ds_read_tr16_b64_v4i16((LAS v4i16_t*)p)); }

#define RLX_AGENT __ATOMIC_RELAXED, __HIP_MEMORY_SCOPE_AGENT
#define XB_TMO      128
#define XB_XCNT(j)  (256  + 64 * (j))
#define XB_XSUB(j)  (1280 + 64 * (j))
#define XB_XGEN(j)  (2304 + 64 * (j))
#define XB_TOP      3328
#define XB_TOPGEN   3392
#define XCD_BAR_WORDS 3456
#define XB_SPIN_CAP (1u << 18)

__device__ __forceinline__ unsigned xb_ld(unsigned* p)              { return __hip_atomic_load(p, __ATOMIC_RELAXED, __HIP_MEMORY_SCOPE_AGENT); }
__device__ __forceinline__ unsigned xb_add(unsigned* p, unsigned v) { return __hip_atomic_fetch_add(p, v, __ATOMIC_RELAXED, __HIP_MEMORY_SCOPE_AGENT); }
__device__ __forceinline__ unsigned xb_xcc_id() { return (unsigned)__builtin_amdgcn_s_getreg((3 << 11) | 20) & 0xFu; }
#define XB_SPIN(cond, bar) do { unsigned _sp = 0; while (cond) { __builtin_amdgcn_s_sleep(1); \
    if ((++_sp & 255u) == 0u) { if (xb_ld(&(bar)[XB_TMO])) break; if (_sp > XB_SPIN_CAP) { atomicAdd(&(bar)[XB_TMO], 1u); break; } } } } while (0)

struct XcdBarrier {
    unsigned* bar; unsigned x;
    volatile LAS unsigned* st;
};

__device__ __forceinline__ XcdBarrier xcd_barrier_post(unsigned* bar, volatile LAS unsigned* st) {
    XcdBarrier b; b.bar = bar; b.x = xb_xcc_id(); b.st = st;
    if (threadIdx.x == 0) (void)xb_add(&bar[XB_XCNT(b.x)], 1u);
    return b;
}
__device__ __forceinline__ void xcd_barrier_complete(unsigned* bar, unsigned x, unsigned& nloc, unsigned& nx) {
    const unsigned G = gridDim.x * gridDim.y * gridDim.z;
    unsigned sum, cnt, mine, sp = 0u;
    for (;;) {
        sum = 0u; cnt = 0u; mine = 0u;
#pragma unroll
        for (unsigned j = 0; j < 16; ++j) { const unsigned c = xb_ld(&bar[XB_XCNT(j)]); sum += c; cnt += (c > 0u) ? 1u : 0u; mine = (j == x) ? c : mine; }
        if (sum == G) break;
        __builtin_amdgcn_s_sleep(1);
        if ((++sp & 255u) == 0u) { if (xb_ld(&bar[XB_TMO])) break; if (sp > XB_SPIN_CAP) { atomicAdd(&bar[XB_TMO], 1u); break; } }
    }
    nloc = mine > 0u ? mine : 1u; nx = cnt > 0u ? cnt : 1u;
}

__device__ __forceinline__ void xcd_barrier(const XcdBarrier& b) {
    asm volatile("s_waitcnt vmcnt(0)" ::: "memory");
    __syncthreads();
    if (threadIdx.x == 0) {
        unsigned* bar = b.bar;
        __builtin_amdgcn_s_waitcnt(0);
        unsigned nloc = b.st[0], nx = b.st[1];
        if (nloc == 0u) { xcd_barrier_complete(bar, b.x, nloc, nx); b.st[0] = nloc; b.st[1] = nx; }
        const unsigned old = xb_add(&bar[XB_XSUB(b.x)], 1u);
        const unsigned gen = old / nloc;
        if (old + 1u == (gen + 1u) * nloc) {
            __builtin_amdgcn_fence(__ATOMIC_RELEASE, "agent");
            asm volatile("s_waitcnt vmcnt(0)" ::: "memory");
            const unsigned og = xb_add(&bar[XB_TOP], 1u);
            const unsigned tg = og / nx;
            if (og + 1u == (tg + 1u) * nx) xb_add(&bar[XB_TOPGEN], 1u);
            else XB_SPIN(xb_ld(&bar[XB_TOPGEN]) == tg, bar);
            __builtin_amdgcn_fence(__ATOMIC_ACQUIRE, "agent");
            xb_add(&bar[XB_XGEN(b.x)], 1u);
            asm volatile("s_waitcnt vmcnt(0)" ::: "memory");
        } else {
            XB_SPIN(xb_ld(&bar[XB_XGEN(b.x)]) == gen, bar);
            __builtin_amdgcn_fence(__ATOMIC_ACQUIRE, "agent");
            asm volatile("s_waitcnt vmcnt(0)" ::: "memory");
        }
    }
    __syncthreads();
}

#ifndef ATT_VAR
#define ATT_VAR 0
#endif
#ifndef REP_MASK
#define REP_MASK 0
#endif
#define NREP(k) (1 + ((REP_MASK >> (k)) & 1))
struct Args { const float* in[26]; float* out; unsigned char* ws; };

__device__ __forceinline__ int dperm(int p) { return p < 16 ? 4 * (p >> 3) + 8 * ((p >> 2) & 1) + (p & 3) : p; }
__device__ __forceinline__ void conv_item(const float* W, int ldn, int K, int c0, bf16* WT, int drow0, bool perm, const float* gain, LAS float* scr, int kb, int lane) {
    const int k0 = 64 * kb;
    float wv[32];
#pragma unroll
    for (int i = 0; i < 32; ++i) wv[i] = __builtin_nontemporal_load(W + (size_t)(k0 + 2 * i + (lane >> 5)) * ldn + c0 + (lane & 31));
    if (gain) {
#pragma unroll
        for (int i = 0; i < 32; ++i) wv[i] *= gain[k0 + 2 * i + (lane >> 5)];
    }
#pragma unroll
    for (int i = 0; i < 32; ++i) scr[(2 * i + (lane >> 5)) * 33 + (lane & 31)] = wv[i];
    LDS_WAIT(); asm volatile("" ::: "memory");
    const int c = lane & 7;
#pragma unroll
    for (int j = 0; j < 4; ++j) { const int n = (lane >> 3) + 8 * j; const int sc = perm ? dperm(n) : n; const LAS float* s = scr + (8 * c) * 33 + sc;
        u32x4 o; o.x = pk2(s[0 * 33], s[1 * 33]); o.y = pk2(s[2 * 33], s[3 * 33]); o.z = pk2(s[4 * 33], s[5 * 33]); o.w = pk2(s[6 * 33], s[7 * 33]);
        *(u32x4*)(WT + (size_t)(drow0 + n) * K + k0 + 8 * c) = o; }
    LDS_WAIT(); asm volatile("" ::: "memory");
}
__device__ __forceinline__ void conv_gu(const float* wg, const float* wu, const float* gain, bf16* WT, LAS float* scr, int r, int lane) {
    const int db = r >> 4, kb = r & 15; const int pn = db >> 3, bj = (db >> 2) & 1, wcb = db & 3;
    conv_item(bj ? wu : wg, DFF, DM, 128 * pn + 32 * wcb, WT, 32 * db, false, gain, scr, kb, lane);
}
__device__ __forceinline__ void conv_win(const float* w, const float* gain, bf16* WT, LAS float* scr, int r, int lane) {
    const int db = r >> 4, kb = r & 15; const int pn = db >> 3, typ = pn >> 2;
    int c0 = 32 * db; bool perm = false;
    if (typ == 3 || typ == 4) { const int bj = (db >> 2) & 1, wcb = db & 3; const int grp = 4 * (pn & 3) + wcb; c0 = (typ == 3 ? 3072 : 4096) + grp * 64 + 32 * bj; perm = (bj == 0); }
    conv_item(w, INC, DM, c0, WT, 32 * db, perm, gain, scr, kb, lane);
}

__device__ __forceinline__ void gmlp_unit(int chunk, const bf16* UV, const bf16* WSP, const float* lng, const float* lnb, const float* bs, bf16* YA, LAS unsigned char* lds) {
    const int tid = threadIdx.x, lane = tid & 63, wid = __builtin_amdgcn_readfirstlane(tid >> 6);
    const size_t tok0 = (size_t)chunk * 128;
    {
        f32x4 g0 = *(const f32x4*)(lng + 8 * lane), g1 = *(const f32x4*)(lng + 8 * lane + 4), b0 = *(const f32x4*)(lnb + 8 * lane), b1 = *(const f32x4*)(lnb + 8 * lane + 4);
        u32x4 wv[16];
#pragma unroll
        for (int i = 0; i < 16; ++i) wv[i] = *(const u32x4*)(UV + (tok0 + 16 * wid + i) * 1024 + 512 + 8 * lane);
#pragma unroll
        for (int i0 = 0; i0 < 16; i0 += 4) {
            f32x4 x0[4], x1[4]; float sm[4], sq[4];
#pragma unroll
            for (int q = 0; q < 4; ++q) { const u32x4 w = wv[i0 + q];
                x0[q] = (f32x4){bflo(w.x), bfhi(w.x), bflo(w.y), bfhi(w.y)}; x1[q] = (f32x4){bflo(w.z), bfhi(w.z), bflo(w.w), bfhi(w.w)};
                sm[q] = (x0[q][0] + x0[q][1]) + (x0[q][2] + x0[q][3]) + (x1[q][0] + x1[q][1]) + (x1[q][2] + x1[q][3]);
                sq[q] = (x0[q][0] * x0[q][0] + x0[q][1] * x0[q][1]) + (x0[q][2] * x0[q][2] + x0[q][3] * x0[q][3]) + (x1[q][0] * x1[q][0] + x1[q][1] * x1[q][1]) + (x1[q][2] * x1[q][2] + x1[q][3] * x1[q][3]); }
#pragma unroll
            for (int o = 1; o < 64; o <<= 1)
#pragma unroll
                for (int q = 0; q < 4; ++q) { sm[q] += __shfl_xor(sm[q], o); sq[q] += __shfl_xor(sq[q], o); }
#pragma unroll
            for (int q = 0; q < 4; ++q) { const int row = 16 * wid + i0 + q;
                const float mean = sm[q] * (1.0f / 512.0f); const float var = fmaxf(sq[q] * (1.0f / 512.0f) - mean * mean, 0.f);
                const float rstd = 1.0f / sqrtf(var + 1e-5f);
                const f32x4 y0 = (x0[q] - mean) * rstd * g0 + b0, y1 = (x1[q] - mean) * rstd * g1 + b1;
                u32x4 o; o.x = pk2(y0[0], y0[1]); o.y = pk2(y0[2], y0[3]); o.z = pk2(y1[0], y1[1]); o.w = pk2(y1[2], y1[3]);
                *(LAS u32x4*)(lds + row * 1024 + ((lane ^ ((row & 3) << 2)) << 4)) = o; }
        }
    }
    __syncthreads();
    {
        const int g = wid, r32 = lane & 31, h8 = lane >> 5;
        const bf16* Wg = WSP + (size_t)g * 128 * 128;
#pragma unroll
        for (int tb = 0; tb < 4; ++tb) {
            f32x16 acc[2];
#pragma unroll
            for (int eb = 0; eb < 2; ++eb)
#pragma unroll
                for (int r = 0; r < 16; ++r) acc[eb][r] = 0.f;
            const int t = 32 * tb + r32; const bf16* up = UV + (tok0 + t) * 1024 + 64 * g; bf16* yp = YA + (tok0 + t) * 512 + 64 * g;
            u32x4 uq[4];
#pragma unroll
            for (int q = 0; q < 4; ++q) uq[q] = *(const u32x4*)(up + 16 * q + 8 * h8);
            const int nks = 2 * (tb + 1);
            bf16x8 wfv[8];
#pragma unroll
            for (int ks = 0; ks < 8; ++ks) if (ks < nks) wfv[ks] = *(const bf16x8*)(Wg + (size_t)(32 * tb + r32) * 128 + 16 * ks + 8 * h8);
#pragma unroll
            for (int ks = 0; ks < 8; ++ks) { if (ks >= nks) break;
                const bf16x8 wf = wfv[ks];
#pragma unroll
                for (int eb = 0; eb < 2; ++eb) {
                    const int q = (lane >> 2) & 3; const int ch = 8 * g + 4 * eb + 2 * ((lane >> 4) & 1) + ((lane & 3) >> 1);
                    const int srow = 16 * ks + 8 * h8 + q;
                    const LAS unsigned char* p0 = lds + srow * 1024 + ((ch ^ (q << 2)) << 4) + 8 * (lane & 1);
                    const s16x4 lo = vtr(p0), hi = vtr(p0 + 4 * 1024);
                    const bf16x8 vf = __builtin_shufflevector(lo, hi, 0, 1, 2, 3, 4, 5, 6, 7);
                    acc[eb] = MFMA32(vf, wf, acc[eb]);
                }
            }
            const float bias = bs[g * 128 + t];
#pragma unroll
            for (int eb = 0; eb < 2; ++eb)
#pragma unroll
                for (int k = 0; k < 2; ++k) {
                    const u32x4 uw4 = uq[2 * eb + k];
                    const auto s0 = __builtin_amdgcn_permlane32_swap(uw4.x, uw4.z, false, false), s1 = __builtin_amdgcn_permlane32_swap(uw4.y, uw4.w, false, false);
                    const unsigned ua_x = s0[0], ua_y = s1[0], ub_x = s0[1], ub_y = s1[1];
                    u32x2 oa, ob;
                    { const int g4 = 2 * k; const float f0 = acc[eb][4 * g4 + 0] + bias, f1 = acc[eb][4 * g4 + 1] + bias, f2 = acc[eb][4 * g4 + 2] + bias, f3 = acc[eb][4 * g4 + 3] + bias;
                      oa.x = pk2(bflo(ua_x) * f0, bfhi(ua_x) * f1); oa.y = pk2(bflo(ua_y) * f2, bfhi(ua_y) * f3); }
                    { const int g4 = 2 * k + 1; const float f0 = acc[eb][4 * g4 + 0] + bias, f1 = acc[eb][4 * g4 + 1] + bias, f2 = acc[eb][4 * g4 + 2] + bias, f3 = acc[eb][4 * g4 + 3] + bias;
                      ob.x = pk2(bflo(ub_x) * f0, bfhi(ub_x) * f1); ob.y = pk2(bflo(ub_y) * f2, bfhi(ub_y) * f3); }
                    const auto r0 = __builtin_amdgcn_permlane32_swap(oa.x, ob.x, false, false), r1 = __builtin_amdgcn_permlane32_swap(oa.y, ob.y, false, false);
                    u32x4 w; w.x = r0[0]; w.y = r1[0]; w.z = r0[1]; w.w = r1[1];
                    *(u32x4*)(yp + 32 * eb + 16 * k + 8 * h8) = w; }
        }
    }
    __syncthreads();
}

template <bool STORE, int VAR = 0> __device__ __forceinline__ void attn_unit(int b, int h, int qb, const bf16* Q, const bf16* K, const bf16* V, bf16* YB, LAS unsigned char* lds, float lam, const float* subln) {
    int tid_ = threadIdx.x; asm volatile("" : "+v"(tid_));
    const int tid = tid_, lane = tid & 63, wid = __builtin_amdgcn_readfirstlane(tid >> 6);
    const int m = wid >> 2, wq = wid & 3, r32 = lane & 31, h8 = lane >> 5;
    const size_t tok0 = (size_t)b * SEQ; const int q0 = qb * 128; const int qrow = q0 + 32 * wq + r32;
    constexpr int STG = 32768; constexpr float THR = 8.0f;
    bf16x8 qf[4];
    { const bf16* qp = Q + (tok0 + qrow) * 1024 + (2 * h + m) * 64 + 8 * h8;
#pragma unroll
      for (int s = 0; s < 4; ++s) qf[s] = *(const bf16x8*)(qp + 16 * s); }
    const int srow0 = tid >> 4, sch = tid & 15;
    const bf16* kg = K + (tok0 + srow0) * 1024 + h * 128 + sch * 8; const bf16* vg = V + (tok0 + srow0) * 1024 + h * 128 + sch * 8;
    unsigned kdst[2], vdst[2];
#pragma unroll
    for (int i = 0; i < 2; ++i) { const int row = srow0 + 32 * i; kdst[i] = (sch >> 3) * 8192 + row * 128 + (((sch & 7) ^ ((row >> 1) & 7)) << 4); vdst[i] = 16384 + row * 256 + ((sch ^ ((row & 3) << 2)) << 4); }
    const int nt = 2 * (qb + 1);
    u32x4 kr[2], vr[2];
#pragma unroll
    for (int t = 0; t < 2; ++t) {
#pragma unroll
        for (int i = 0; i < 2; ++i) { kr[i] = *(const u32x4*)(kg + (size_t)(64 * t + 32 * i) * 1024); vr[i] = *(const u32x4*)(vg + (size_t)(64 * t + 32 * i) * 1024); }
#pragma unroll
        for (int i = 0; i < 2; ++i) { *(LAS u32x4*)(lds + t * STG + kdst[i]) = kr[i]; *(LAS u32x4*)(lds + t * STG + vdst[i]) = vr[i]; }
    }
    __syncthreads();
    f32x16 oT[4], sT[2]; bf16x8 pf[4];
#pragma unroll
    for (int d = 0; d < 4; ++d)
#pragma unroll
        for (int r = 0; r < 16; ++r) oT[d][r] = 0.f;
#pragma unroll
    for (int s = 0; s < 4; ++s) pf[s] = (bf16x8){0, 0, 0, 0, 0, 0, 0, 0};
    float mrun = 0.f, lsum = 0.f;
    f32x16 negm;
#pragma unroll
    for (int r = 0; r < 16; ++r) negm[r] = 0.f;
    const int kq = (lane >> 2) & 3;
    const int ksw = (r32 >> 1) & 7;
    const unsigned koff = m * 8192 + r32 * 128, kc0 = ((0 + h8) ^ ksw) << 4, kc1 = ((2 + h8) ^ ksw) << 4, kc2 = ((4 + h8) ^ ksw) << 4, kc3 = ((6 + h8) ^ ksw) << 4;
    const unsigned voff = 16384 + (4 * h8 + kq) * 256 + 8 * (lane & 1); const int vch = 2 * ((lane >> 4) & 1) + ((lane & 3) >> 1);
#define SB() __builtin_amdgcn_sched_barrier(0)
#define ATT_KLD(dst, st, kb) do { const LAS unsigned char* kp_ = lds + (st) + koff + (kb) * 4096; \
        dst[0] = *(const LAS bf16x8*)(kp_ + kc0); dst[1] = *(const LAS bf16x8*)(kp_ + kc1); dst[2] = *(const LAS bf16x8*)(kp_ + kc2); dst[3] = *(const LAS bf16x8*)(kp_ + kc3); } while (0)
#define ATT_VLD(lo, hi, st, d) do { const LAS unsigned char* vp_ = lds + (st) + voff + ((((4 * (d)) + vch) ^ (kq << 2)) << 4); \
        _Pragma("unroll") for (int s = 0; s < 4; ++s) { lo[s] = vtr(vp_ + (16 * s) * 256); hi[s] = vtr(vp_ + (16 * s + 8) * 256); } } while (0)
#define ATT_VF(lo, hi, s) __builtin_shufflevector(lo[s], hi[s], 0, 1, 2, 3, 4, 5, 6, 7)
#define ATT_MMA(stv, sts, DO_S) do { \
        bf16x8 kfa_[4], kfb_[4]; s16x4 vla_[4], vha_[4], vlb_[4], vhb_[4]; \
        __builtin_amdgcn_s_setprio(1); \
        if (DO_S) { ATT_KLD(kfa_, sts, 0); } ATT_VLD(vla_, vha_, stv, 0); SB(); \
        if (DO_S) { ATT_KLD(kfb_, sts, 1); \
            sT[0] = MFMA32(kfa_[0], qf[0], negm); \
            _Pragma("unroll") for (int s = 1; s < 4; ++s) sT[0] = MFMA32(kfa_[s], qf[s], sT[0]); SB(); \
            sT[1] = MFMA32(kfb_[0], qf[0], negm); \
            _Pragma("unroll") for (int s = 1; s < 4; ++s) sT[1] = MFMA32(kfb_[s], qf[s], sT[1]); SB(); } \
        ATT_VLD(vlb_, vhb_, stv, 1); \
        _Pragma("unroll") for (int s = 0; s < 4; ++s) oT[0] = MFMA32(ATT_VF(vla_, vha_, s), pf[s], oT[0]); SB(); \
        ATT_VLD(vla_, vha_, stv, 2); \
        _Pragma("unroll") for (int s = 0; s < 4; ++s) oT[1] = MFMA32(ATT_VF(vlb_, vhb_, s), pf[s], oT[1]); SB(); \
        ATT_VLD(vlb_, vhb_, stv, 3); \
        _Pragma("unroll") for (int s = 0; s < 4; ++s) oT[2] = MFMA32(ATT_VF(vla_, vha_, s), pf[s], oT[2]); SB(); \
        _Pragma("unroll") for (int s = 0; s < 4; ++s) oT[3] = MFMA32(ATT_VF(vlb_, vhb_, s), pf[s], oT[3]); __builtin_amdgcn_s_setprio(0); SB(); } while (0)
#define MAX3(a, b, c) ({ float r_; asm("v_max3_f32 %0, %1, %2, %3" : "=v"(r_) : "v"(a), "v"(b), "v"(c)); r_; })
#define ATT_SOFTMAX(j) do { \
        if ((j) >= nt - 2) { \
            _Pragma("unroll") for (int kb = 0; kb < 2; ++kb) \
            _Pragma("unroll") for (int r = 0; r < 16; ++r) { const int kv_ = 64 * (j) + 32 * kb + crow(r, h8); if (kv_ > qrow) sT[kb][r] = -INFINITY; } } \
        float ta_ = MAX3(sT[0][0], sT[0][1], sT[0][2]), tb_ = MAX3(sT[1][0], sT[1][1], sT[1][2]); \
        _Pragma("unroll") for (int r = 3; r < 15; r += 2) { ta_ = MAX3(ta_, sT[0][r], sT[0][r + 1]); tb_ = MAX3(tb_, sT[1][r], sT[1][r + 1]); } \
        float tmax_ = MAX3(ta_, tb_, sT[0][15]); tmax_ = MAX3(tmax_, sT[1][15], sT[1][15]); \
        { auto rr_ = __builtin_amdgcn_permlane32_swap(__float_as_uint(tmax_), __float_as_uint(tmax_), false, false); tmax_ = MAX3(__uint_as_float(rr_[0]), __uint_as_float(rr_[1]), __uint_as_float(rr_[1])); } \
        if ((j) == 0 || __any(tmax_ > THR)) { const float dl_ = ((j) == 0) ? tmax_ : fmaxf(tmax_, 0.f); mrun += dl_; const float al_ = __builtin_amdgcn_exp2f(-dl_); lsum *= al_; \
            _Pragma("unroll") for (int d = 0; d < 4; ++d) _Pragma("unroll") for (int r = 0; r < 16; ++r) oT[d][r] *= al_; \
            _Pragma("unroll") for (int kb = 0; kb < 2; ++kb) _Pragma("unroll") for (int r = 0; r < 16; ++r) sT[kb][r] -= dl_; \
            _Pragma("unroll") for (int r = 0; r < 16; ++r) negm[r] = -mrun; } \
        _Pragma("unroll") for (int kb = 0; kb < 2; ++kb) \
        _Pragma("unroll") for (int r = 0; r < 16; ++r) sT[kb][r] = __builtin_amdgcn_exp2f(sT[kb][r]); \
        float p0_ = sT[0][0] + sT[0][1], p1_ = sT[0][2] + sT[0][3], p2_ = sT[1][0] + sT[1][1], p3_ = sT[1][2] + sT[1][3]; \
        _Pragma("unroll") for (int r = 4; r < 16; r += 4) { p0_ += sT[0][r]; p1_ += sT[0][r + 2]; p2_ += sT[1][r]; p3_ += sT[1][r + 2]; p0_ += sT[0][r + 1]; p1_ += sT[0][r + 3]; p2_ += sT[1][r + 1]; p3_ += sT[1][r + 3]; } \
        lsum += (p0_ + p1_) + (p2_ + p3_); \
        _Pragma("unroll") for (int s = 0; s < 4; ++s) { u32x4 w_; \
            w_.x = pg8::cvt_pk_bf16(sT[s >> 1][8 * (s & 1) + 0], sT[s >> 1][8 * (s & 1) + 1]); w_.y = pg8::cvt_pk_bf16(sT[s >> 1][8 * (s & 1) + 2], sT[s >> 1][8 * (s & 1) + 3]); \
            w_.z = pg8::cvt_pk_bf16(sT[s >> 1][8 * (s & 1) + 4], sT[s >> 1][8 * (s & 1) + 5]); w_.w = pg8::cvt_pk_bf16(sT[s >> 1][8 * (s & 1) + 6], sT[s >> 1][8 * (s & 1) + 7]); \
            pf[s] = __builtin_bit_cast(bf16x8, w_); } } while (0)
    if (m == 1) __builtin_amdgcn_s_barrier();
    int stV = 0, stS = 0, stW = 2 * STG;
    for (int it = 0; it < nt; ++it) {
        const bool ld = (it + 2 < nt);
        if (ld) {
#pragma unroll
            for (int i = 0; i < 2; ++i) { kr[i] = *(const u32x4*)(kg + (size_t)(64 * (it + 2) + 32 * i) * 1024); vr[i] = *(const u32x4*)(vg + (size_t)(64 * (it + 2) + 32 * i) * 1024); }
        }
        if (VAR != 2 && VAR != 3) ATT_MMA(stV, stS, true);
        asm volatile("s_waitcnt lgkmcnt(0)" ::: "memory"); __builtin_amdgcn_s_barrier(); asm volatile("" ::: "memory");
        if (VAR != 1 && VAR != 3) ATT_SOFTMAX(it);
        if (ld) {
#pragma unroll
            for (int i = 0; i < 2; ++i) { *(LAS u32x4*)(lds + stW + kdst[i]) = kr[i]; *(LAS u32x4*)(lds + stW + vdst[i]) = vr[i]; }
        }
        __syncthreads();
        stV = stS; stS = (stS == 3 * STG) ? 0 : stS + STG; stW = (stW == 3 * STG) ? 0 : stW + STG;
    }
    ATT_MMA(stV, stS, false);
    __syncthreads();
    __syncthreads();
    if (m == 0) __builtin_amdgcn_s_barrier();
#undef ATT_MMA
#undef ATT_KLD
#undef ATT_VLD
#undef ATT_VF
#undef SB
#undef ATT_SOFTMAX
#undef MAX3
    { auto rr = __builtin_amdgcn_permlane32_swap(__float_as_uint(lsum), __float_as_uint(lsum), false, false); lsum = __uint_as_float(rr[0]) + __uint_as_float(rr[1]); }
    const float inv = 1.0f / lsum;
    LAS float* cmb = (LAS float*)lds + wq * 4096;
    if (m == 1) {
#pragma unroll
        for (int d = 0; d < 4; ++d)
#pragma unroll
            for (int r4 = 0; r4 < 4; ++r4) *(LAS f32x4*)(cmb + ((d * 4 + r4) * 64 + lane) * 4) = (f32x4){oT[d][4 * r4] * inv, oT[d][4 * r4 + 1] * inv, oT[d][4 * r4 + 2] * inv, oT[d][4 * r4 + 3] * inv};
    }
    __syncthreads();
    if (m == 0) {
        float sq = 0.f;
#pragma unroll
        for (int d = 0; d < 4; ++d)
#pragma unroll
            for (int r4 = 0; r4 < 4; ++r4) { const f32x4 c4 = *(const LAS f32x4*)(cmb + ((d * 4 + r4) * 64 + lane) * 4);
#pragma unroll
                for (int i = 0; i < 4; ++i) { const float y = oT[d][4 * r4 + i] * inv - lam * c4[i]; oT[d][4 * r4 + i] = y; sq += y * y; } }
        { auto rr = __builtin_amdgcn_permlane32_swap(__float_as_uint(sq), __float_as_uint(sq), false, false); sq = __uint_as_float(rr[0]) + __uint_as_float(rr[1]); }
        const float rn = __builtin_amdgcn_rsqf(sq * (1.0f / 128.0f) + 1e-6f) * (1.0f - LAM_INIT);
        bf16* yp = YB + (tok0 + qrow) * 1024 + h * 128;
#pragma unroll
        for (int d = 0; d < 4; ++d)
#pragma unroll
            for (int k = 0; k < 2; ++k) { u32x2 oa, ob;
                { const int g4 = 2 * k, d0 = 32 * d + 8 * g4 + 4 * h8; const f32x4 sg = *(const f32x4*)(subln + d0);
                  oa.x = pk2(oT[d][4 * g4 + 0] * rn * sg[0], oT[d][4 * g4 + 1] * rn * sg[1]); oa.y = pk2(oT[d][4 * g4 + 2] * rn * sg[2], oT[d][4 * g4 + 3] * rn * sg[3]); }
                { const int g4 = 2 * k + 1, d0 = 32 * d + 8 * g4 + 4 * h8; const f32x4 sg = *(const f32x4*)(subln + d0);
                  ob.x = pk2(oT[d][4 * g4 + 0] * rn * sg[0], oT[d][4 * g4 + 1] * rn * sg[1]); ob.y = pk2(oT[d][4 * g4 + 2] * rn * sg[2], oT[d][4 * g4 + 3] * rn * sg[3]); }
                const auto r0 = __builtin_amdgcn_permlane32_swap(oa.x, ob.x, false, false), r1 = __builtin_amdgcn_permlane32_swap(oa.y, ob.y, false, false);
                u32x4 w; w.x = r0[0]; w.y = r1[0]; w.z = r0[1]; w.w = r1[1];
                if (STORE) *(u32x4*)(yp + 32 * d + 16 * k + 8 * h8) = w; else if (w.x == 0x12345678u && w.y == 0x9abcdef0u) *(u32x4*)(yp + 32 * d + 16 * k + 8 * h8) = w; }
    }
    __syncthreads();
}

__global__ void __launch_bounds__(NWAVES * 64, 2) mega_fwd(Args args) {
    extern __shared__ __attribute__((aligned(16))) unsigned char lds_raw[];
    LAS unsigned char* lds = (LAS unsigned char*)lds_raw;
    const int tid = threadIdx.x, lane = tid & 63, wave = __builtin_amdgcn_readfirstlane(tid >> 6);
    const int G = gridDim.x, bx = blockIdx.x; const int vcu = (G % 8 == 0) ? (bx % 8) * (G / 8) + bx / 8 : bx;
    unsigned char* ws = args.ws;
    { LAS unsigned* misc0 = (LAS unsigned*)(lds + 131072); if (tid < 64) misc0[tid] = 0u; }
    __syncthreads();
    const XcdBarrier gbar = xcd_barrier_post((unsigned*)(ws + WS_CTL), (volatile LAS unsigned*)(lds + 131072) + 8);
    const float* x = args.in[0]; const int* positions = (const int*)args.in[1];
    const float *ffn1_norm = args.in[2], *ffn1_wg = args.in[3], *ffn1_wu = args.in[4], *ffn1_wd = args.in[5], *mix_norm = args.in[6], *w_in = args.in[7];
    const float *a_ln_g = args.in[8], *a_ln_b = args.in[9], *a_w_s = args.in[10], *a_b_s = args.in[11], *a_w_proj = args.in[12];
    const float *b_qn = args.in[13], *b_kn = args.in[14], *lq1 = args.in[15], *lk1 = args.in[16], *lq2 = args.in[17], *lk2 = args.in[18], *b_subln = args.in[19], *b_w_proj = args.in[20];
    const float *w_out = args.in[21], *ffn2_norm = args.in[22], *ffn2_wg = args.in[23], *ffn2_wu = args.in[24], *ffn2_wd = args.in[25];
    float* out = args.out;
    bf16 *W1GU = (bf16*)(ws + WS_W1GU), *W1D = (bf16*)(ws + WS_W1D), *WIN = (bf16*)(ws + WS_WIN), *WPA = (bf16*)(ws + WS_WPA), *WPB = (bf16*)(ws + WS_WPB), *WO = (bf16*)(ws + WS_WO);
    bf16 *W2GU = (bf16*)(ws + WS_W2GU), *W2D = (bf16*)(ws + WS_W2D), *WSP = (bf16*)(ws + WS_WSP);
    float *ROPE = (float*)(ws + WS_ROPE), *SS = (float*)(ws + WS_SS);
    bf16 *XB = (bf16*)(ws + WS_XB), *YA = (bf16*)(ws + WS_YA), *H = (bf16*)(ws + WS_H), *SG = (bf16*)(ws + WS_SG), *UV = (bf16*)(ws + WS_UV), *MM = (bf16*)(ws + WS_MM);
    bf16 *QB = (bf16*)(ws + WS_Q), *YB = (bf16*)(ws + WS_YB), *KB = (bf16*)(ws + WS_K), *VB = (bf16*)(ws + WS_V);

    for (int rep = 0; rep < NREP(0); ++rep) {
        LAS float* scr = (LAS float*)(lds + wave * 16384);
        const int gw = vcu * NWAVES + wave, NGW = G * NWAVES;
        constexpr int I_GU = 176 * 16, I_D = 32 * 44, I_IN = 192 * 16, I_PA = 32 * 8, I_PB = 32 * 16, I_WO = 32 * 16;
        constexpr int NITEMS = 2 * I_GU + 2 * I_D + I_IN + I_PA + I_PB + I_WO;
        for (int it = gw; it < NITEMS; it += NGW) {
            int r = it;
            if (r < I_GU) { conv_gu(ffn1_wg, ffn1_wu, ffn1_norm, W1GU, scr, r, lane); continue; } r -= I_GU;
            if (r < I_GU) { conv_gu(ffn2_wg, ffn2_wu, ffn2_norm, W2GU, scr, r, lane); continue; } r -= I_GU;
            if (r < I_IN) { conv_win(w_in, mix_norm, WIN, scr, r, lane); continue; } r -= I_IN;
            if (r < I_D) { conv_item(ffn1_wd, DM, DFF, 32 * (r / 44), W1D, 32 * (r / 44), false, nullptr, scr, r % 44, lane); continue; } r -= I_D;
            if (r < I_D) { conv_item(ffn2_wd, DM, DFF, 32 * (r / 44), W2D, 32 * (r / 44), false, nullptr, scr, r % 44, lane); continue; } r -= I_D;
            if (r < I_PA) { conv_item(a_w_proj, DM, AW, 32 * (r >> 3), WPA, 32 * (r >> 3), false, nullptr, scr, r & 7, lane); continue; } r -= I_PA;
            if (r < I_PB) { conv_item(b_w_proj, DM, DM, 32 * (r >> 4), WPB, 32 * (r >> 4), false, nullptr, scr, r & 15, lane); continue; } r -= I_PB;
            conv_item(w_out, DM, DM, 32 * (r >> 4), WO, 32 * (r >> 4), false, nullptr, scr, r & 15, lane);
        }
        const int gt = vcu * (NWAVES * 64) + tid, NGT = G * NWAVES * 64;
        for (int i = gt; i < 8 * 128 * 128; i += NGT) { const int s = i & 127, t = (i >> 7) & 127; WSP[i] = (bf16)f2bf(s <= t ? a_w_s[i] : 0.f); }
        for (int i = gt; i < MT * 8; i += NGT) { const int row = i >> 3, j = i & 7;
            const float inv = (j == 0) ? 1.0f : exp2f(-(float)j * 0.125f * 18.931568569324174f);
            const float ang = (float)positions[row] * inv;
            ROPE[(size_t)row * 16 + j] = cosf(ang); ROPE[(size_t)row * 16 + 8 + j] = sinf(ang); }
        for (int row0 = gw; row0 < MT; row0 += 4 * NGW) {
            f32x4 v[4][4];
#pragma unroll
            for (int q = 0; q < 4; ++q) { const int row = row0 + q * NGW; const f32x4* xr = (const f32x4*)(x + (size_t)(row < MT ? row : row0) * DM) + lane;
#pragma unroll
                for (int j = 0; j < 4; ++j) v[q][j] = __builtin_nontemporal_load(xr + 64 * j); }
#pragma unroll
            for (int q = 0; q < 4; ++q) { const int row = row0 + q * NGW; if (row >= MT) break; float sq = 0.f;
                unsigned long long* o8 = (unsigned long long*)(XB + (size_t)row * DM) + lane;
#pragma unroll
                for (int j = 0; j < 4; ++j) { const f32x4 t = v[q][j]; sq += (t[0] * t[0] + t[1] * t[1]) + (t[2] * t[2] + t[3] * t[3]);
                    o8[64 * j] = (unsigned long long)pk2(t[0], t[1]) | ((unsigned long long)pk2(t[2], t[3]) << 32); }
                sq = wave_sum(sq);
                if (lane < 16) SS[(size_t)row * 16 + lane] = (lane == 0) ? sq : 0.f; }
        }
    }
    xcd_barrier(gbar);
    if (REP_MASK & 256) { for (int i = 0; i < 8; ++i) xcd_barrier(gbar); }
    if (REP_MASK & 512) { pg8::Gemm g{XB, W1GU, MT, 2 * DFF, DM}; pg8::StaticOrder S; S.init(MT, 2 * DFF, G, bx);
      pg8::EpiPlainH E{H, DFF};
      pg8::gemm_phase<pg8::EpiPlainH, pg8::StaticOrder, true, true>(lds, g, S, E); xcd_barrier(gbar); }
    for (int rep = 0; rep < NREP(1); ++rep) { if (rep) xcd_barrier(gbar); pg8::Gemm g{XB, W1GU, MT, 2 * DFF, DM}; pg8::StaticOrder S; S.init(MT, 2 * DFF, G, bx);
      pg8::rs_tags_clear(lds); pg8::EpiSwiglu E{H, SS, DFF, lds};
      pg8::gemm_phase<pg8::EpiSwiglu, pg8::StaticOrder, true, true>(lds, g, S, E); }
    xcd_barrier(gbar);
    for (int rep = 0; rep < NREP(2); ++rep) { if (rep) xcd_barrier(gbar); pg8::Gemm g{H, W1D, MT, DM, DFF}; pg8::StaticOrder S; S.init(MT, DM, G, bx);
      pg8::EpiResid<true> E{x, out, XB, SS, 0.5f};
      pg8::gemm_phase<pg8::EpiResid<true>, pg8::StaticOrder, true, true>(lds, g, S, E); }
    xcd_barrier(gbar);
    for (int rep = 0; rep < NREP(3); ++rep) { if (rep) xcd_barrier(gbar); pg8::Gemm g{XB, WIN, MT, INC, DM}; pg8::StaticOrder S; S.init(MT, INC, G, bx);
      pg8::rs_tags_clear(lds); pg8::EpiWin E{SS, SG, UV, QB, KB, VB, ROPE, b_qn, b_kn, QSCALE, lds};
      pg8::gemm_phase<pg8::EpiWin, pg8::StaticOrder, true, true>(lds, g, S, E); }
    xcd_barrier(gbar);
    {
        for (int rep = 0; rep < NREP(5); ++rep) for (int c = vcu; c < MT / 128; c += G) gmlp_unit(c, UV, WSP, a_ln_g, a_ln_b, a_b_s, YA, lds);
        float d1 = lq1[lane] * lk1[lane], d2 = lq2[lane] * lk2[lane];
        d1 = wave_sum(d1); d2 = wave_sum(d2);
        const float lam = expf(d1) - expf(d2) + LAM_INIT;
        for (int slot = vcu; slot < BATCH * NH * 4; slot += G) { const int bh = slot >> 2, sub = slot & 3;
            for (int rep = 0; rep < NREP(4); ++rep)
            for (int r = 0; r < 8; ++r) { const int rp = (r & 1) ? (r >> 1) : 7 - (r >> 1); const int qb = 4 * rp + ((sub + r) & 3);
                if (rep + 1 < NREP(4)) attn_unit<false, ATT_VAR>(bh >> 3, bh & 7, qb, QB, KB, VB, YB, lds, lam, b_subln);
                else attn_unit<true>(bh >> 3, bh & 7, qb, QB, KB, VB, YB, lds, lam, b_subln); } }
    }
    xcd_barrier(gbar);
    { pg8::Gemm g{YA, WPA, MT, DM, AW}; pg8::StaticOrder S; S.init(MT, DM, G, bx);
      pg8::EpiGate<true> E{SG, 0, MM};
      pg8::gemm_phase<pg8::EpiGate<true>, pg8::StaticOrder, true, true>(lds, g, S, E); }
    __syncthreads();
    { pg8::Gemm g{YB, WPB, MT, DM, DM}; pg8::StaticOrder S; S.init(MT, DM, G, bx);
      pg8::EpiGate<false> E{SG, 1024, MM};
      pg8::gemm_phase<pg8::EpiGate<false>, pg8::StaticOrder, true, true>(lds, g, S, E); }
    xcd_barrier(gbar);
    { pg8::Gemm g{MM, WO, MT, DM, DM}; pg8::StaticOrder S; S.init(MT, DM, G, bx);
      pg8::EpiResid<true> E{out, out, XB, SS, 1.0f};
      pg8::gemm_phase<pg8::EpiResid<true>, pg8::StaticOrder, true, true>(lds, g, S, E); }
    xcd_barrier(gbar);
    for (int rep = 0; rep < NREP(7); ++rep) { if (rep) xcd_barrier(gbar); pg8::Gemm g{XB, W2GU, MT, 2 * DFF, DM}; pg8::StaticOrder S; S.init(MT, 2 * DFF, G, bx);
      pg8::rs_tags_clear(lds); pg8::EpiSwiglu E{H, SS, DFF, lds};
      pg8::gemm_phase<pg8::EpiSwiglu, pg8::StaticOrder, true, true>(lds, g, S, E); }
    xcd_barrier(gbar);
    { pg8::Gemm g{H, W2D, MT, DM, DFF}; pg8::StaticOrder S; S.init(MT, DM, G, bx);
      pg8::EpiResid<false> E{out, out, nullptr, nullptr, 0.5f};
      pg8::gemm_phase<pg8::EpiResid<false>, pg8::StaticOrder, true, true>(lds, g, S, E); }
}

extern "C" void kernel_launch(void* const* d_in, const int* in_sizes, int n_in, void* d_out, int out_size, void* d_ws, size_t ws_size, hipStream_t stream) {
    static int grid = 0;
    if (grid == 0) {
        if (n_in != 26 || in_sizes[0] != MT * DM || out_size != MT * DM || ws_size < WS_END) { fprintf(stderr, "kernel_launch: unexpected shapes (n_in %d, in0 %d, out %d, ws %zu); nothing launched\n", n_in, n_in > 0 ? in_sizes[0] : -1, out_size, ws_size); grid = -1; return; }
        int dev = 0, cus = 0, per_cu = 0;
        if (hipGetDevice(&dev) != hipSuccess || hipDeviceGetAttribute(&cus, hipDeviceAttributeMultiprocessorCount, dev) != hipSuccess) { grid = -1; return; }
        if (hipFuncSetAttribute((const void*)mega_fwd, hipFuncAttributeMaxDynamicSharedMemorySize, LDS_BYTES) != hipSuccess) { fprintf(stderr, "kernel_launch: hipFuncSetAttribute failed\n"); grid = -1; return; }
        if (hipOccupancyMaxActiveBlocksPerMultiprocessor(&per_cu, (const void*)mega_fwd, NWAVES * 64, LDS_BYTES) != hipSuccess || per_cu < 1) { fprintf(stderr, "kernel_launch: occupancy query says %d blocks per CU\n", per_cu); (void)hipGetLastError(); grid = -1; return; }
        grid = cus;
    }
    if (grid < 0) return;
    if (hipMemsetAsync((char*)d_ws + WS_CTL, 0, CTL_ZERO_BYTES, stream) != hipSuccess) { fprintf(stderr, "kernel_launch: memset of the barrier words failed\n"); return; }
    Args a{};
    for (int i = 0; i < 26; ++i) a.in[i] = (const float*)d_in[i];
    a.out = (float*)d_out; a.ws = (unsigned char*)d_ws;
    void* kargs[] = {&a};
    hipError_t e = hipLaunchCooperativeKernel((const void*)mega_fwd, dim3(grid), dim3(NWAVES * 64), kargs, LDS_BYTES, stream);
    if (e != hipSuccess) fprintf(stderr, "kernel_launch: cooperative launch failed: %s (grid %d)\n", hipGetErrorString(e), grid);
}
```

```cpp
#include <hip/hip_runtime.h>
#include <hip/hip_cooperative_groups.h>
#include <cstdio>
#include <cstdint>
namespace cg = cooperative_groups;
namespace pg8 {
#define PG8_LAS __attribute__((address_space(3)))
typedef unsigned short bf16_t;
typedef short bf16x8 __attribute__((ext_vector_type(8)));
typedef float f32x4 __attribute__((ext_vector_type(4)));
typedef unsigned u32x4 __attribute__((ext_vector_type(4)));
constexpr int BM = 256, BK = 64, HALF = 128, HTB = HALF * BK * 2  , STAGE_BYTES = 8 * HTB, NXCD = 8, WGM = 8;

__host__ __device__ __forceinline__ int lds_byte(int r, int c) { const int st = (r >> 4) * 2 + (c >> 5), rr = r & 15, cc = c & 31, ob = rr * 64 + cc * 2; return st * 1024 + (ob ^ (((ob >> 9) & 1) << 5)); }
__host__ __device__ __forceinline__ void stage_rc(int b, int& R, int& C) { const int st = b / 1024, sb = b % 1024, swz = sb ^ (((sb >> 9) & 1) << 5); R = (st >> 1) * 16 + swz / 64; C = (st & 1) * 32 + (swz % 64) / 2; }
__host__ __device__ __forceinline__ int perm32(int rho) { const int n = rho >> 4, i = rho & 15; return 8 * (i >> 2) + 4 * n + (i & 3); }

struct Unit { int pm, pn; };
struct Gemm { const bf16_t* A; const bf16_t* Bt; int M, N, K; };

struct StaticOrder {
    int nM, nN, nwg, G, c;
    __host__ __device__ void init(int M, int N, int G_, int c_) { nM = M / BM; nN = N / BM; nwg = nM * nN; G = G_; c = c_; }
    __host__ __device__ bool next(int i, Unit& u) const {
        const long L = (long)i * G + c; if (L >= nwg) return false;
        int wgid = (int)L; { const int q = nwg / NXCD, r = nwg % NXCD, xcd = wgid % NXCD, off = wgid / NXCD; wgid = (xcd < r ? xcd * (q + 1) : r * (q + 1) + (xcd - r) * q) + off; }
        const int nig = WGM * nN, gid = wgid / nig, fm = gid * WGM, gsz = (nM - fm) < WGM ? (nM - fm) : WGM;
        u.pm = fm + ((wgid % nig) % gsz); u.pn = (wgid % nig) / gsz; return true;
    }
    __device__ __forceinline__ void a_ready(const Unit&) const {}
    __device__ __forceinline__ void done(const Unit&) const {}
};

__device__ __forceinline__ unsigned cvt_pk_bf16(float lo, float hi) { unsigned r; asm volatile("v_cvt_pk_bf16_f32 %0, %1, %2" : "=v"(r) : "v"(lo), "v"(hi)); return r; }
typedef float f32x2 __attribute__((ext_vector_type(2)));
__device__ __forceinline__ f32x2 gelu_pk(f32x2 v) {
    const f32x2 av = __builtin_elementwise_abs(v), d = av * 0.2316418882f + 1.0f;
    f32x2 t; t.x = __builtin_amdgcn_rcpf(d.x); t.y = __builtin_amdgcn_rcpf(d.y);
    f32x2 q = t * 0.5307027145f + (-0.7265760135f); q = q * t + 0.7107068705f; q = q * t + (-0.142248368f); q = q * t + 0.127414796f; q = q * t;
    const f32x2 s = (v * v) * (-0.72134752044f);
    f32x2 e; e.x = __builtin_amdgcn_exp2f(s.x); e.y = __builtin_amdgcn_exp2f(s.y);
    const f32x2 m = v * (q * e), r = v - m;
    f32x2 o; o.x = v.x < 0.f ? m.x : r.x; o.y = v.y < 0.f ? m.y : r.y; return o;
}
__device__ __forceinline__ f32x4 gelu4(f32x4 v) { f32x2 a = gelu_pk((f32x2){v[0], v[1]}), b = gelu_pk((f32x2){v[2], v[3]}); return (f32x4){a.x, a.y, b.x, b.y}; }
__device__ __forceinline__ float sigm1(float x) { return __builtin_amdgcn_rcpf(1.0f + __builtin_amdgcn_exp2f(-1.4426950408889634f * x)); }
__device__ __forceinline__ f32x4 sigm4(f32x4 v) { return (f32x4){sigm1(v[0]), sigm1(v[1]), sigm1(v[2]), sigm1(v[3])}; }
__device__ __forceinline__ u32x4 pack8(f32x4 a, f32x4 b) { u32x4 w; w.x = cvt_pk_bf16(a[0], a[1]); w.y = cvt_pk_bf16(a[2], a[3]); w.z = cvt_pk_bf16(b[0], b[1]); w.w = cvt_pk_bf16(b[2], b[3]); return w; }
__device__ __forceinline__ void unpack8(u32x4 w, f32x4& a, f32x4& b) {
    a = (f32x4){__uint_as_float(w.x << 16), __uint_as_float(w.x & 0xffff0000u), __uint_as_float(w.y << 16), __uint_as_float(w.y & 0xffff0000u)};
    b = (f32x4){__uint_as_float(w.z << 16), __uint_as_float(w.z & 0xffff0000u), __uint_as_float(w.w << 16), __uint_as_float(w.w & 0xffff0000u)}; }
constexpr int SSN = 16;
__device__ __forceinline__ float row_rstd(const float* ss, int row) {
    const f32x4* p = (const f32x4*)(ss + (size_t)row * SSN); const f32x4 a = p[0], b = p[1], c = p[2], d = p[3];
    const f32x4 s = (a + b) + (c + d); const float t = (s[0] + s[1]) + (s[2] + s[3]);
    return __builtin_amdgcn_rsqf(t * (1.0f / 1024.0f) + 1e-6f);
}

__device__ __forceinline__ void rstd8(const float* ss, int row0, int fq, float (&rs)[2][4]) {
    f32x4 t[2][4];
#pragma unroll
    for (int ai = 0; ai < 2; ++ai)
#pragma unroll
        for (int m = 0; m < 4; ++m) t[ai][m] = *(const f32x4*)(ss + (size_t)(row0 + ai * HALF + m * 16) * SSN + 4 * fq);
#pragma unroll
    for (int ai = 0; ai < 2; ++ai)
#pragma unroll
        for (int m = 0; m < 4; ++m) { float v = (t[ai][m][0] + t[ai][m][1]) + (t[ai][m][2] + t[ai][m][3]); v += __shfl_xor(v, 16); v += __shfl_xor(v, 32);
            rs[ai][m] = __builtin_amdgcn_rsqf(v * (1.0f / 1024.0f) + 1e-6f); }
}
typedef PG8_LAS float* rs_tab_t;
constexpr int RS_TAB_OFF = 131072 + 1024, RS_TAG_OFF = 131072 + 1024 + 4096;
__device__ __forceinline__ void rs_tags_clear(PG8_LAS unsigned char* lds) { if (threadIdx.x < 8) ((PG8_LAS int*)(lds + RS_TAG_OFF))[threadIdx.x] = -1; asm volatile("s_waitcnt lgkmcnt(0)" ::: "memory"); __builtin_amdgcn_s_barrier(); }
__device__ __forceinline__ void rs_cached(PG8_LAS unsigned char* lds, const float* ss, const Unit& u, int wr, int wc, int fr, int fq, float (&rs)[2][4]) {
    const int wid = wr * 4 + wc; rs_tab_t tab = (rs_tab_t)(lds + RS_TAB_OFF) + wid * 128; PG8_LAS int* tagp = (PG8_LAS int*)(lds + RS_TAG_OFF) + wid;
    const int tag = __builtin_amdgcn_readfirstlane(*tagp);
    if (tag != u.pm) {
        rstd8(ss, u.pm * BM + wr * 64 + fr, fq, rs);
        if (fq == 0) {
#pragma unroll
            for (int ai = 0; ai < 2; ++ai)
#pragma unroll
                for (int m = 0; m < 4; ++m) tab[ai * 64 + m * 16 + fr] = rs[ai][m];
        }
        if (fr == 0 && fq == 0) *tagp = u.pm;
    } else {
#pragma unroll
        for (int ai = 0; ai < 2; ++ai)
#pragma unroll
            for (int m = 0; m < 4; ++m) rs[ai][m] = tab[ai * 64 + m * 16 + fr];
    }
}
struct EpiSwiglu {
    static constexpr bool PERM = true, AFTER_DRAIN = false;
    bf16_t* H; const float* ss; int ldh; PG8_LAS unsigned char* lds;
    __device__ __forceinline__ void operator()(const f32x4 (&acc)[2][2][4][2], const Unit& u, int wr, int wc, int fr, int fq) const {
        const int row0 = u.pm * BM + wr * 64 + fr, col0 = u.pn * HALF + wc * 32 + 8 * fq;
        float rsv[2][4]; rs_cached(lds, ss, u, wr, wc, fr, fq, rsv);
#pragma unroll
        for (int ai = 0; ai < 2; ++ai)
#pragma unroll
            for (int m = 0; m < 4; ++m) { const int row = row0 + ai * HALF + m * 16; const float rs = rsv[ai][m]; const float c1 = -1.4426950408889634f * rs, c2 = rs * rs;
                f32x4 o[2];
#pragma unroll
                for (int n = 0; n < 2; ++n) {
                    const f32x4 ga = acc[ai][0][m][n], t = ga * c1; f32x4 sg;
#pragma unroll
                    for (int i = 0; i < 4; ++i) sg[i] = __builtin_amdgcn_rcpf(1.0f + __builtin_amdgcn_exp2f(t[i]));
                    o[n] = (ga * acc[ai][1][m][n]) * (sg * c2); }
                *(u32x4*)(H + (size_t)row * ldh + col0) = pack8(o[0], o[1]); }
    }
};
template <bool WX> struct EpiResid {
    static constexpr bool PERM = true, AFTER_DRAIN = false;
    const float* base; float* out; bf16_t* XB; float* ss; float scale;
    __device__ __forceinline__ void operator()(const f32x4 (&acc)[2][2][4][2], const Unit& u, int wr, int wc, int fr, int fq) const {
        const int row0 = u.pm * BM + wr * 64 + fr, col0 = u.pn * BM + wc * 32 + 8 * fq;
#pragma unroll
        for (int ai = 0; ai < 2; ++ai) {
            f32x4 bv[4][2][2];
#pragma unroll
            for (int m = 0; m < 4; ++m)
#pragma unroll
                for (int bj = 0; bj < 2; ++bj) { const size_t off = (size_t)(row0 + ai * HALF + m * 16) * 1024 + col0 + bj * HALF; bv[m][bj][0] = *(const f32x4*)(base + off); bv[m][bj][1] = *(const f32x4*)(base + off + 4); }
#pragma unroll
            for (int m = 0; m < 4; ++m) { const int row = row0 + ai * HALF + m * 16; float sq = 0.f;
#pragma unroll
                for (int bj = 0; bj < 2; ++bj) { const size_t off = (size_t)row * 1024 + col0 + bj * HALF;
                    const f32x4 b0 = bv[m][bj][0], b1 = bv[m][bj][1];
                    const f32x4 o0 = b0 + acc[ai][bj][m][0] * scale, o1 = b1 + acc[ai][bj][m][1] * scale;
                    __builtin_nontemporal_store(o0, (f32x4*)(out + off)); __builtin_nontemporal_store(o1, (f32x4*)(out + off + 4));
                    if (WX) { *(u32x4*)(XB + off) = pack8(o0, o1);
                        sq += (o0[0] * o0[0] + o0[1] * o0[1]) + (o0[2] * o0[2] + o0[3] * o0[3]) + (o1[0] * o1[0] + o1[1] * o1[1]) + (o1[2] * o1[2] + o1[3] * o1[3]); } }
                if (WX) { sq += __shfl_xor(sq, 16); sq += __shfl_xor(sq, 32); if (fq == 0) ss[(size_t)row * SSN + u.pn * 4 + wc] = sq; } } }
    }
};
template <bool FIRST> struct EpiGate {
    static constexpr bool PERM = true, AFTER_DRAIN = false;
    const bf16_t* SG; int sgoff; bf16_t* MM;
    __device__ __forceinline__ void operator()(const f32x4 (&acc)[2][2][4][2], const Unit& u, int wr, int wc, int fr, int fq) const {
        const int row0 = u.pm * BM + wr * 64 + fr, col0 = u.pn * BM + wc * 32 + 8 * fq;
#pragma unroll
        for (int ai = 0; ai < 2; ++ai) {
            u32x4 sgv[4][2], mmv[4][2];
#pragma unroll
            for (int m = 0; m < 4; ++m)
#pragma unroll
                for (int bj = 0; bj < 2; ++bj) { const int row = row0 + ai * HALF + m * 16, col = col0 + bj * HALF; sgv[m][bj] = *(const u32x4*)(SG + (size_t)row * 2048 + sgoff + col);
                    if (!FIRST) mmv[m][bj] = *(const u32x4*)(MM + (size_t)row * 1024 + col); }
#pragma unroll
            for (int m = 0; m < 4; ++m) { const int row = row0 + ai * HALF + m * 16;
#pragma unroll
                for (int bj = 0; bj < 2; ++bj) { const int col = col0 + bj * HALF;
                    f32x4 s0, s1; unpack8(sgv[m][bj], s0, s1);
                    f32x4 o0 = s0 * acc[ai][bj][m][0], o1 = s1 * acc[ai][bj][m][1];
                    bf16_t* mp = MM + (size_t)row * 1024 + col;
                    if (!FIRST) { f32x4 p0, p1; unpack8(mmv[m][bj], p0, p1); o0 += p0; o1 += p1; }
                    *(u32x4*)mp = pack8(o0, o1); } } }
    }
};
struct EpiWin {
    static constexpr bool PERM = true, AFTER_DRAIN = false;
    const float* ss; bf16_t *SG, *UV, *QB, *KB, *VB; const float* rope; const float *qg, *kg; float qscale; PG8_LAS unsigned char* lds;
    __device__ __forceinline__ void operator()(const f32x4 (&acc)[2][2][4][2], const Unit& u, int wr, int wc, int fr, int fq) const {
        const int row0 = u.pm * BM + wr * 64 + fr; const int typ = u.pn >> 2;
        float rsv[2][4]; rs_cached(lds, ss, u, wr, wc, fr, fq, rsv);
        if (typ == 3 || typ == 4) {
            const float* gp = (typ == 3) ? qg : kg; bf16_t* dst = (typ == 3) ? QB : KB; const float osc = (typ == 3) ? qscale : 1.0f;
            const int grp = 4 * (u.pn & 3) + wc;
            f32x4 gn[2][2];
            gn[0][0] = *(const f32x4*)(gp + (fq < 2 ? 4 * fq : 8 * fq)); gn[0][1] = *(const f32x4*)(gp + (fq < 2 ? 8 + 4 * fq : 8 * fq + 4));
            gn[1][0] = *(const f32x4*)(gp + 32 + 8 * fq); gn[1][1] = *(const f32x4*)(gp + 32 + 8 * fq + 4);
#pragma unroll
            for (int bj = 0; bj < 2; ++bj)
#pragma unroll
                for (int n = 0; n < 2; ++n) gn[bj][n] = gn[bj][n] * osc;
#pragma unroll
            for (int ai = 0; ai < 4; ++ai) {
                f32x4 csv[2], snv[2];
#pragma unroll
                for (int m = 0; m < 2; ++m) { const float* rp = rope + (size_t)(row0 + (ai >> 1) * HALF + ((ai & 1) * 2 + m) * 16) * 16 + 4 * (fq & 1); csv[m] = *(const f32x4*)rp; snv[m] = *(const f32x4*)(rp + 8); }
#pragma unroll
                for (int m = 0; m < 2; ++m) { const int AI = ai >> 1, M = (ai & 1) * 2 + m; const int row = row0 + AI * HALF + M * 16;
                    f32x4 v[2][2]; float sq = 0.f;
#pragma unroll
                    for (int bj = 0; bj < 2; ++bj)
#pragma unroll
                        for (int n = 0; n < 2; ++n) { v[bj][n] = acc[AI][bj][M][n]; const f32x4 x = v[bj][n]; sq += (x[0] * x[0] + x[1] * x[1]) + (x[2] * x[2] + x[3] * x[3]); }
                    sq += __shfl_xor(sq, 16); sq += __shfl_xor(sq, 32);
                    const float rs = rsv[AI][M]; const float rn = rs * __builtin_amdgcn_rsqf(rs * rs * sq * (1.0f / 64.0f) + 1e-6f);
                    const f32x4 cs = csv[m], sn = snv[m];
                    f32x4 r1 = v[0][0] * rn * gn[0][0], r2 = v[0][1] * rn * gn[0][1];
                    if (fq < 2) { const f32x4 a = r1 * cs - r2 * sn, b = r2 * cs + r1 * sn; r1 = a; r2 = b; }
                    const f32x4 t0 = v[1][0] * rn * gn[1][0], t1 = v[1][1] * rn * gn[1][1];
                    bf16_t* dp = dst + (size_t)row * 1024 + grp * 64 + 8 * fq;
                    *(u32x4*)dp = pack8(r1, r2); *(u32x4*)(dp + 32) = pack8(t0, t1); } }
            return;
        }
        bf16_t* dst; int ldc, colt;
        if (typ < 2) { dst = SG; ldc = 2048; colt = u.pn * BM; } else if (typ == 2) { dst = UV; ldc = 1024; colt = (u.pn - 8) * BM; } else { dst = VB; ldc = 1024; colt = (u.pn - 20) * BM; }
        const int col0 = colt + wc * 32 + 8 * fq;
#pragma unroll
        for (int ai = 0; ai < 2; ++ai)
#pragma unroll
            for (int m = 0; m < 4; ++m) { const int row = row0 + ai * HALF + m * 16; const float rs = rsv[ai][m];
#pragma unroll
                for (int bj = 0; bj < 2; ++bj) { f32x4 v0, v1;
                    if (typ < 2) { const float c1 = -1.4426950408889634f * rs; const f32x4 t0 = acc[ai][bj][m][0] * c1, t1 = acc[ai][bj][m][1] * c1;
#pragma unroll
                        for (int i = 0; i < 4; ++i) { v0[i] = __builtin_amdgcn_rcpf(1.0f + __builtin_amdgcn_exp2f(t0[i])); v1[i] = __builtin_amdgcn_rcpf(1.0f + __builtin_amdgcn_exp2f(t1[i])); } }
                    else { v0 = acc[ai][bj][m][0] * rs; v1 = acc[ai][bj][m][1] * rs; if (typ == 2) { v0 = gelu4(v0); v1 = gelu4(v1); } }
                    if (typ < 2) __builtin_nontemporal_store(pack8(v0, v1), (u32x4*)(dst + (size_t)row * ldc + col0 + bj * HALF)); else *(u32x4*)(dst + (size_t)row * ldc + col0 + bj * HALF) = pack8(v0, v1); } }
    }
};
struct EpiPlainH {
    static constexpr bool PERM = true, AFTER_DRAIN = false;
    bf16_t* H; int ldh;
    __device__ __forceinline__ void operator()(const f32x4 (&acc)[2][2][4][2], const Unit& u, int wr, int wc, int fr, int fq) const {
        const int row0 = u.pm * BM + wr * 64 + fr, col0 = u.pn * HALF + wc * 32 + 8 * fq;
#pragma unroll
        for (int ai = 0; ai < 2; ++ai)
#pragma unroll
            for (int m = 0; m < 4; ++m) { const int row = row0 + ai * HALF + m * 16;
                *(u32x4*)(H + (size_t)row * ldh + col0) = pack8(acc[ai][0][m][0] + acc[ai][1][m][0], acc[ai][0][m][1] + acc[ai][1][m][1]); }
    }
};
template <class Epi, class Sched, bool ALIGN_EPI = false, bool SP2 = false>
__device__ __forceinline__ void gemm_phase(PG8_LAS unsigned char* lds, const Gemm g, const Sched& S, const Epi& E) {
    int tid_ = threadIdx.x; asm volatile("" : "+v"(tid_));
    const int tid = tid_, wid = __builtin_amdgcn_readfirstlane(tid >> 6), lane = tid & 63, wr = wid >> 2, wc = wid & 3, fr = lane & 15, fq = lane >> 4;
    int K_ = g.K; asm volatile("" : "+s"(K_));
    const int K = K_, nt = K / BK;
    unsigned voffA[2], voffB[2];
#pragma unroll
    for (int i = 0; i < 2; ++i) { int R, C; stage_rc(tid * 16 + i * 8192, R, C); const int Rb = Epi::PERM ? ((R & ~31) + perm32(R & 31)) : R;
        voffA[i] = (unsigned)(R * K + C) * 2u; voffB[i] = (unsigned)(Rb * K + C) * 2u; }
    const size_t kstep = (size_t)(BK * 2);
    const size_t hstep = (size_t)HALF * K * 2;
    const size_t tstep = 2 * hstep;
    const unsigned ldsw = (unsigned)wid * 1024u;
    const int aoff = lds_byte(wr * 64 + fr, fq * 8), boff = lds_byte(wc * 32 + fr, fq * 8);
#define PG8_SA(b, h) (((b) * 2 + (h)) * HTB)
#define PG8_SB(b, h) ((4 + (b) * 2 + (h)) * HTB)
#define PG8_STAGE(bufoff, gbase, voff) do { _Pragma("unroll") for (int _i = 0; _i < 2; ++_i) \
        __builtin_amdgcn_global_load_lds((const unsigned*)((const char*)(gbase) + (voff)[_i]), (PG8_LAS unsigned*)(lds + (bufoff) + ldsw + _i * 8192), 16, 0, 0); } while (0)
#define PG8_LDA(dst, b, h) do { _Pragma("unroll") for (int m = 0; m < 4; ++m) _Pragma("unroll") for (int k = 0; k < 2; ++k) dst[m][k] = *(const PG8_LAS bf16x8*)(lds + PG8_SA(b, h) + aoff + m * 2048 + k * 1024); } while (0)
#define PG8_LDB(dst, b, h) do { _Pragma("unroll") for (int n = 0; n < 2; ++n) _Pragma("unroll") for (int k = 0; k < 2; ++k) dst[n][k] = *(const PG8_LAS bf16x8*)(lds + PG8_SB(b, h) + boff + n * 2048 + k * 1024); } while (0)
#define PG8_MMA(ai, bj, At, Bt) do { __builtin_amdgcn_s_setprio(1); _Pragma("unroll") for (int m = 0; m < 4; ++m) _Pragma("unroll") for (int n = 0; n < 2; ++n) _Pragma("unroll") for (int k = 0; k < 2; ++k) \
        acc[ai][bj][m][n] = __builtin_amdgcn_mfma_f32_16x16x32_bf16(Bt[n][k], At[m][k], acc[ai][bj][m][n], 0, 0, 0); __builtin_amdgcn_s_setprio(0); } while (0)
#define PG8_WAIT_V(n) asm volatile("s_waitcnt vmcnt(" #n ")" ::: "memory")
#define PG8_WAIT_L(n) asm volatile("s_waitcnt lgkmcnt(" #n ")" ::: "memory")
#define PG8_BAR __builtin_amdgcn_s_barrier()
#define PG8_SCHED __builtin_amdgcn_sched_barrier(0)
    Unit cur, nxt; int ui = 0;
    if (!S.next(0, cur)) return;
    f32x4 acc[2][2][4][2];
#pragma unroll
    for (int a = 0; a < 2; ++a)
#pragma unroll
        for (int b = 0; b < 2; ++b)
#pragma unroll
            for (int m = 0; m < 4; ++m)
#pragma unroll
                for (int n = 0; n < 2; ++n) acc[a][b][m][n] = (f32x4){0.f, 0.f, 0.f, 0.f};
    bf16x8 At[4][2], B0[2][2], B1[2][2];
    const char* cA = (const char*)g.A + (size_t)cur.pm * tstep; const char* cB = (const char*)g.Bt + (size_t)cur.pn * tstep;
    S.a_ready(cur);
    if constexpr (SP2) {
        PG8_STAGE(PG8_SB(0, 0), cB, voffB); PG8_STAGE(PG8_SB(0, 1), cB + hstep, voffB); PG8_STAGE(PG8_SA(0, 0), cA, voffA); PG8_STAGE(PG8_SA(0, 1), cA + hstep, voffA);
        if (wr == 1) PG8_BAR;
        PG8_WAIT_V(2); PG8_BAR;
        PG8_STAGE(PG8_SB(1, 0), cB + kstep, voffB); PG8_STAGE(PG8_SA(1, 0), cA + kstep, voffA); PG8_STAGE(PG8_SB(1, 1), cB + hstep + kstep, voffB);
        PG8_WAIT_V(6); PG8_BAR;
    } else {
        PG8_STAGE(PG8_SB(0, 0), cB, voffB); PG8_STAGE(PG8_SA(0, 0), cA, voffA); PG8_STAGE(PG8_SB(0, 1), cB + hstep, voffB); PG8_STAGE(PG8_SA(0, 1), cA + hstep, voffA);
        if (wr == 1) PG8_BAR;
        PG8_WAIT_V(4); PG8_BAR;
        PG8_STAGE(PG8_SB(1, 0), cB + kstep, voffB); PG8_STAGE(PG8_SA(1, 0), cA + kstep, voffA); PG8_STAGE(PG8_SB(1, 1), cB + hstep + kstep, voffB);
        PG8_WAIT_V(6); PG8_BAR;
    }
    for (;;) {
        const bool has_next = S.next(ui + 1, nxt);
        const char* nA = has_next ? (const char*)g.A + (size_t)nxt.pm * tstep : cA; const char* nB = has_next ? (const char*)g.Bt + (size_t)nxt.pn * tstep : cB;
        for (int t = 0; t < nt; t += 2) {
            const bool last = (t == nt - 2);
            const char* a1 = cA + (size_t)(t + 1) * kstep;
            const char* a2 = last ? nA : cA + (size_t)(t + 2) * kstep; const char* b2 = last ? nB : cB + (size_t)(t + 2) * kstep;
            const char* a3 = a2 + kstep; const char* b3 = b2 + kstep;
            if (last && has_next) S.a_ready(nxt);
            if constexpr (SP2) {
            PG8_LDB(B0, 0, 0); PG8_LDB(B1, 0, 1); PG8_SCHED; PG8_LDA(At, 0, 0); PG8_STAGE(PG8_SA(1, 1), a1 + hstep, voffA);
            PG8_WAIT_V(8); PG8_WAIT_L(0); PG8_BAR; PG8_MMA(0, 0, At, B0); PG8_MMA(0, 1, At, B1); PG8_BAR; PG8_SCHED;
            PG8_LDA(At, 0, 1); PG8_STAGE(PG8_SB(0, 0), b2, voffB); PG8_STAGE(PG8_SB(0, 1), b2 + hstep, voffB); PG8_STAGE(PG8_SA(0, 0), a2, voffA);
            PG8_WAIT_V(8); PG8_WAIT_L(0); PG8_BAR; PG8_MMA(1, 0, At, B0); PG8_MMA(1, 1, At, B1); PG8_BAR; PG8_SCHED;
            PG8_LDB(B0, 1, 0); PG8_LDB(B1, 1, 1); PG8_SCHED; PG8_LDA(At, 1, 0); PG8_STAGE(PG8_SA(0, 1), a2 + hstep, voffA);
            PG8_WAIT_V(8); PG8_WAIT_L(0); PG8_BAR; PG8_MMA(0, 0, At, B0); PG8_MMA(0, 1, At, B1); PG8_BAR; PG8_SCHED;
            PG8_LDA(At, 1, 1); PG8_STAGE(PG8_SB(1, 0), b3, voffB); PG8_STAGE(PG8_SB(1, 1), b3 + hstep, voffB); PG8_STAGE(PG8_SA(1, 0), a3, voffA);
            PG8_WAIT_V(8); PG8_WAIT_L(0); PG8_BAR; PG8_MMA(1, 0, At, B0); PG8_MMA(1, 1, At, B1); PG8_BAR; PG8_SCHED;
            } else {
            PG8_LDB(B0, 0, 0); PG8_SCHED; PG8_LDA(At, 0, 0); PG8_STAGE(PG8_SA(1, 1), a1 + hstep, voffA);
            PG8_WAIT_L(8); PG8_BAR; PG8_WAIT_L(0); PG8_MMA(0, 0, At, B0); PG8_BAR; PG8_SCHED;
            PG8_LDB(B1, 0, 1); PG8_STAGE(PG8_SB(0, 0), b2, voffB);
            PG8_BAR; PG8_WAIT_L(0); PG8_MMA(0, 1, At, B1); PG8_BAR;
            PG8_LDA(At, 0, 1); PG8_STAGE(PG8_SA(0, 0), a2, voffA);
            PG8_BAR; PG8_WAIT_L(0); PG8_MMA(1, 0, At, B0); PG8_BAR; PG8_SCHED;
            PG8_STAGE(PG8_SB(0, 1), b2 + hstep, voffB);
            PG8_WAIT_V(6); PG8_BAR; PG8_MMA(1, 1, At, B1); PG8_BAR;
            PG8_LDB(B0, 1, 0); PG8_SCHED; PG8_LDA(At, 1, 0); PG8_STAGE(PG8_SA(0, 1), a2 + hstep, voffA);
            PG8_WAIT_L(8); PG8_BAR; PG8_WAIT_L(0); PG8_MMA(0, 0, At, B0); PG8_BAR; PG8_SCHED;
            PG8_LDB(B1, 1, 1); PG8_STAGE(PG8_SB(1, 0), b3, voffB);
            PG8_BAR; PG8_WAIT_L(0); PG8_MMA(0, 1, At, B1); PG8_BAR;
            PG8_LDA(At, 1, 1); PG8_STAGE(PG8_SA(1, 0), a3, voffA);
            PG8_BAR; PG8_WAIT_L(0); PG8_MMA(1, 0, At, B0); PG8_BAR; PG8_SCHED;
            PG8_STAGE(PG8_SB(1, 1), b3 + hstep, voffB);
            PG8_WAIT_V(6); PG8_BAR; PG8_MMA(1, 1, At, B1); PG8_BAR;
            }
        }
        if constexpr (ALIGN_EPI) { if (wr == 0) PG8_BAR; }
        if constexpr (!Epi::AFTER_DRAIN) { E(acc, cur, wr, wc, fr, fq); S.done(cur); }
        if (!has_next) break;
#pragma unroll
        for (int a = 0; a < 2; ++a)
#pragma unroll
            for (int b = 0; b < 2; ++b)
#pragma unroll
                for (int m = 0; m < 4; ++m)
#pragma unroll
                    for (int n = 0; n < 2; ++n) acc[a][b][m][n] = (f32x4){0.f, 0.f, 0.f, 0.f};
        cur = nxt; cA = nA; cB = nB; ++ui;
        if constexpr (ALIGN_EPI) { if (wr == 1) PG8_BAR; }
    }
    PG8_WAIT_V(0);
    if constexpr (!ALIGN_EPI) { if (wr == 0) PG8_BAR; }
    PG8_BAR;
    if constexpr (Epi::AFTER_DRAIN) { E.fused(acc, cur, wr, wc, fr, fq, lds, wid, lane); S.done(cur); }
#undef PG8_SA
#undef PG8_SB
#undef PG8_STAGE
#undef PG8_LDA
#undef PG8_LDB
#undef PG8_MMA
#undef PG8_WAIT_V
#undef PG8_WAIT_L
#undef PG8_BAR
#undef PG8_SCHED
}
}

constexpr int BATCH = 8, SEQ = 4096, DM = 1024, DFF = 2816, AW = 512, NH = 8, INC = 6144;
constexpr int MT = BATCH * SEQ;
constexpr int NWAVES = 8;
constexpr float QSCALE = 0.125f * 1.4426950408889634f;
constexpr float LAM_INIT = 0.2f;

constexpr size_t MiB = 1u << 20;
constexpr size_t WS_W1GU = 0;
constexpr size_t WS_W1D  = WS_W1GU + (size_t)2 * DFF * DM * 2;
constexpr size_t WS_WIN  = WS_W1D + (size_t)DM * DFF * 2;
constexpr size_t WS_WPA  = WS_WIN + (size_t)INC * DM * 2;
constexpr size_t WS_WPB  = WS_WPA + (size_t)DM * AW * 2;
constexpr size_t WS_WO   = WS_WPB + (size_t)DM * DM * 2;
constexpr size_t WS_W2GU = WS_WO + (size_t)DM * DM * 2;
constexpr size_t WS_W2D  = WS_W2GU + (size_t)2 * DFF * DM * 2;
constexpr size_t WS_WSP  = WS_W2D + (size_t)DM * DFF * 2;
constexpr size_t WS_ROPE = WS_WSP + (size_t)8 * 128 * 128 * 2;
constexpr size_t WS_SS   = WS_ROPE + (size_t)MT * 16 * 4;
constexpr size_t WS_R0END = WS_SS + (size_t)MT * 16 * 4;
static_assert(WS_R0END <= 64 * MiB, "weights region");
constexpr size_t WS_CTL = 60 * MiB, CTL_ZERO_BYTES = 65536;
static_assert(WS_R0END <= WS_CTL, "ctl");
constexpr size_t WS_XB = 64 * MiB;
constexpr size_t WS_YA = WS_XB;
constexpr size_t WS_H  = 128 * MiB;
constexpr size_t WS_SG = 128 * MiB;
constexpr size_t WS_UV = 256 * MiB;
constexpr size_t WS_MM = WS_UV;
constexpr size_t WS_Q  = 320 * MiB;
constexpr size_t WS_YB = WS_Q;
constexpr size_t WS_K  = 384 * MiB;
constexpr size_t WS_V  = 448 * MiB;
constexpr size_t WS_END = 512 * MiB;
static_assert(WS_H + (size_t)MT * DFF * 2 <= WS_Q, "H overlay");

constexpr int LDS_BYTES = 147456;

#define LAS __attribute__((address_space(3)))
typedef unsigned short bf16;
typedef float f32x4 __attribute__((ext_vector_type(4)));
typedef float f32x16 __attribute__((ext_vector_type(16)));
typedef short bf16x8 __attribute__((ext_vector_type(8)));
typedef short s16x4 __attribute__((ext_vector_type(4)));
typedef unsigned u32x4 __attribute__((ext_vector_type(4)));
typedef unsigned u32x2 __attribute__((ext_vector_type(2)));
#define LDS_WAIT() asm volatile("s_waitcnt lgkmcnt(0)" ::: "memory")
#define MFMA32(a, b, c) __builtin_amdgcn_mfma_f32_32x32x16_bf16((a), (b), (c), 0, 0, 0)
__device__ __forceinline__ unsigned f2bf(float f) { unsigned u = __builtin_bit_cast(unsigned, f); return (u + 0x7fffu + ((u >> 16) & 1u)) >> 16; }
__device__ __forceinline__ unsigned pk2(float lo, float hi) { typedef float f2_t __attribute__((ext_vector_type(2))); typedef __bf16 b2_t __attribute__((ext_vector_type(2))); const f2_t v = {lo, hi}; return __builtin_bit_cast(unsigned, __builtin_convertvector(v, b2_t)); }
__device__ __forceinline__ float bflo(unsigned w) { return __uint_as_float(w << 16); }
__device__ __forceinline__ float bfhi(unsigned w) { return __uint_as_float(w & 0xffff0000u); }
__device__ __forceinline__ float wave_sum(float v) {
#pragma unroll
    for (int o = 1; o < 64; o <<= 1) v += __shfl_xor(v, o);
    return v;
}
__device__ __forceinline__ int crow(int r, int hi) { return (r & 3) + 8 * (r >> 2) + 4 * hi; }
typedef short v4i16_t __attribute__((ext_vector_type(4)));
__device__ __forceinline__ s16x4 vtr(const LAS unsigned char* p) { return __builtin_bit_cast(s16x4, __builtin_amdgcn_ds_read_tr16_b64_v4i16((LAS v4i16_t*)p)); }

#define RLX_AGENT __ATOMIC_RELAXED, __HIP_MEMORY_SCOPE_AGENT
#define XB_TMO      128
#define XB_XCNT(j)  (256  + 64 * (j))
#define XB_XSUB(j)  (1280 + 64 * (j))
#define XB_XGEN(j)  (2304 + 64 * (j))
#define XB_TOP      3328
#define XB_TOPGEN   3392
#define XCD_BAR_WORDS 3456
#define XB_SPIN_CAP (1u << 18)

__device__ __forceinline__ unsigned xb_ld(unsigned* p)              { return __hip_atomic_load(p, __ATOMIC_RELAXED, __HIP_MEMORY_SCOPE_AGENT); }
__device__ __forceinline__ unsigned xb_add(unsigned* p, unsigned v) { return __hip_atomic_fetch_add(p, v, __ATOMIC_RELAXED, __HIP_MEMORY_SCOPE_AGENT); }
__device__ __forceinline__ unsigned xb_xcc_id() { return (unsigned)__builtin_amdgcn_s_getreg((3 << 11) | 20) & 0xFu; }
#define XB_SPIN(cond, bar) do { unsigned _sp = 0; while (cond) { __builtin_amdgcn_s_sleep(1); \
    if ((++_sp & 255u) == 0u) { if (xb_ld(&(bar)[XB_TMO])) break; if (_sp > XB_SPIN_CAP) { atomicAdd(&(bar)[XB_TMO], 1u); break; } } } } while (0)

struct XcdBarrier {
    unsigned* bar; unsigned x;
    volatile LAS unsigned* st;
};

__device__ __forceinline__ XcdBarrier xcd_barrier_post(unsigned* bar, volatile LAS unsigned* st) {
    XcdBarrier b; b.bar = bar; b.x = xb_xcc_id(); b.st = st;
    if (threadIdx.x == 0) (void)xb_add(&bar[XB_XCNT(b.x)], 1u);
    return b;
}
__device__ __forceinline__ void xcd_barrier_complete(unsigned* bar, unsigned x, unsigned& nloc, unsigned& nx) {
    const unsigned G = gridDim.x * gridDim.y * gridDim.z;
    unsigned sum, cnt, mine, sp = 0u;
    for (;;) {
        sum = 0u; cnt = 0u; mine = 0u;
#pragma unroll
        for (unsigned j = 0; j < 16; ++j) { const unsigned c = xb_ld(&bar[XB_XCNT(j)]); sum += c; cnt += (c > 0u) ? 1u : 0u; mine = (j == x) ? c : mine; }
        if (sum == G) break;
        __builtin_amdgcn_s_sleep(1);
        if ((++sp & 255u) == 0u) { if (xb_ld(&bar[XB_TMO])) break; if (sp > XB_SPIN_CAP) { atomicAdd(&bar[XB_TMO], 1u); break; } }
    }
    nloc = mine > 0u ? mine : 1u; nx = cnt > 0u ? cnt : 1u;
}

__device__ __forceinline__ void xcd_barrier(const XcdBarrier& b) {
    asm volatile("s_waitcnt vmcnt(0)" ::: "memory");
    __syncthreads();
    if (threadIdx.x == 0) {
        unsigned* bar = b.bar;
        __builtin_amdgcn_s_waitcnt(0);
        unsigned nloc = b.st[0], nx = b.st[1];
        if (nloc == 0u) { xcd_barrier_complete(bar, b.x, nloc, nx); b.st[0] = nloc; b.st[1] = nx; }
        const unsigned old = xb_add(&bar[XB_XSUB(b.x)], 1u);
        const unsigned gen = old / nloc;
        if (old + 1u == (gen + 1u) * nloc) {
            __builtin_amdgcn_fence(__ATOMIC_RELEASE, "agent");
            asm volatile("s_waitcnt vmcnt(0)" ::: "memory");
            const unsigned og = xb_add(&bar[XB_TOP], 1u);
            const unsigned tg = og / nx;
            if (og + 1u == (tg + 1u) * nx) xb_add(&bar[XB_TOPGEN], 1u);
            else XB_SPIN(xb_ld(&bar[XB_TOPGEN]) == tg, bar);
            __builtin_amdgcn_fence(__ATOMIC_ACQUIRE, "agent");
            xb_add(&bar[XB_XGEN(b.x)], 1u);
            asm volatile("s_waitcnt vmcnt(0)" ::: "memory");
        } else {
            XB_SPIN(xb_ld(&bar[XB_XGEN(b.x)]) == gen, bar);
            __builtin_amdgcn_fence(__ATOMIC_ACQUIRE, "agent");
            asm volatile("s_waitcnt vmcnt(0)" ::: "memory");
        }
    }
    __syncthreads();
}

#ifndef ATT_VAR
#define ATT_VAR 0
#endif
#ifndef REP_MASK
#define REP_MASK 0
#endif
#define NREP(k) (1 + ((REP_MASK >> (k)) & 1))
struct Args { const float* in[26]; float* out; unsigned char* ws; };

__device__ __forceinline__ int dperm(int p) { return p < 16 ? 4 * (p >> 3) + 8 * ((p >> 2) & 1) + (p & 3) : p; }
__device__ __forceinline__ void conv_item(const float* W, int ldn, int K, int c0, bf16* WT, int drow0, bool perm, const float* gain, LAS float* scr, int kb, int lane) {
    const int k0 = 64 * kb;
    float wv[32];
#pragma unroll
    for (int i = 0; i < 32; ++i) wv[i] = __builtin_nontemporal_load(W + (size_t)(k0 + 2 * i + (lane >> 5)) * ldn + c0 + (lane & 31));
    if (gain) {
#pragma unroll
        for (int i = 0; i < 32; ++i) wv[i] *= gain[k0 + 2 * i + (lane >> 5)];
    }
#pragma unroll
    for (int i = 0; i < 32; ++i) scr[(2 * i + (lane >> 5)) * 33 + (lane & 31)] = wv[i];
    LDS_WAIT(); asm volatile("" ::: "memory");
    const int c = lane & 7;
#pragma unroll
    for (int j = 0; j < 4; ++j) { const int n = (lane >> 3) + 8 * j; const int sc = perm ? dperm(n) : n; const LAS float* s = scr + (8 * c) * 33 + sc;
        u32x4 o; o.x = pk2(s[0 * 33], s[1 * 33]); o.y = pk2(s[2 * 33], s[3 * 33]); o.z = pk2(s[4 * 33], s[5 * 33]); o.w = pk2(s[6 * 33], s[7 * 33]);
        *(u32x4*)(WT + (size_t)(drow0 + n) * K + k0 + 8 * c) = o; }
    LDS_WAIT(); asm volatile("" ::: "memory");
}
__device__ __forceinline__ void conv_gu(const float* wg, const float* wu, const float* gain, bf16* WT, LAS float* scr, int r, int lane) {
    const int db = r >> 4, kb = r & 15; const int pn = db >> 3, bj = (db >> 2) & 1, wcb = db & 3;
    conv_item(bj ? wu : wg, DFF, DM, 128 * pn + 32 * wcb, WT, 32 * db, false, gain, scr, kb, lane);
}
__device__ __forceinline__ void conv_win(const float* w, const float* gain, bf16* WT, LAS float* scr, int r, int lane) {
    const int db = r >> 4, kb = r & 15; const int pn = db >> 3, typ = pn >> 2;
    int c0 = 32 * db; bool perm = false;
    if (typ == 3 || typ == 4) { const int bj = (db >> 2) & 1, wcb = db & 3; const int grp = 4 * (pn & 3) + wcb; c0 = (typ == 3 ? 3072 : 4096) + grp * 64 + 32 * bj; perm = (bj == 0); }
    conv_item(w, INC, DM, c0, WT, 32 * db, perm, gain, scr, kb, lane);
}

__device__ __forceinline__ void gmlp_unit(int chunk, const bf16* UV, const bf16* WSP, const float* lng, const float* lnb, const float* bs, bf16* YA, LAS unsigned char* lds) {
    const int tid = threadIdx.x, lane = tid & 63, wid = __builtin_amdgcn_readfirstlane(tid >> 6);
    const size_t tok0 = (size_t)chunk * 128;
    {
        f32x4 g0 = *(const f32x4*)(lng + 8 * lane), g1 = *(const f32x4*)(lng + 8 * lane + 4), b0 = *(const f32x4*)(lnb + 8 * lane), b1 = *(const f32x4*)(lnb + 8 * lane + 4);
        u32x4 wv[16];
#pragma unroll
        for (int i = 0; i < 16; ++i) wv[i] = *(const u32x4*)(UV + (tok0 + 16 * wid + i) * 1024 + 512 + 8 * lane);
#pragma unroll
        for (int i0 = 0; i0 < 16; i0 += 4) {
            f32x4 x0[4], x1[4]; float sm[4], sq[4];
#pragma unroll
            for (int q = 0; q < 4; ++q) { const u32x4 w = wv[i0 + q];
                x0[q] = (f32x4){bflo(w.x), bfhi(w.x), bflo(w.y), bfhi(w.y)}; x1[q] = (f32x4){bflo(w.z), bfhi(w.z), bflo(w.w), bfhi(w.w)};
                sm[q] = (x0[q][0] + x0[q][1]) + (x0[q][2] + x0[q][3]) + (x1[q][0] + x1[q][1]) + (x1[q][2] + x1[q][3]);
                sq[q] = (x0[q][0] * x0[q][0] + x0[q][1] * x0[q][1]) + (x0[q][2] * x0[q][2] + x0[q][3] * x0[q][3]) + (x1[q][0] * x1[q][0] + x1[q][1] * x1[q][1]) + (x1[q][2] * x1[q][2] + x1[q][3] * x1[q][3]); }
#pragma unroll
            for (int o = 1; o < 64; o <<= 1)
#pragma unroll
                for (int q = 0; q < 4; ++q) { sm[q] += __shfl_xor(sm[q], o); sq[q] += __shfl_xor(sq[q], o); }
#pragma unroll
            for (int q = 0; q < 4; ++q) { const int row = 16 * wid + i0 + q;
                const float mean = sm[q] * (1.0f / 512.0f); const float var = fmaxf(sq[q] * (1.0f / 512.0f) - mean * mean, 0.f);
                const float rstd = 1.0f / sqrtf(var + 1e-5f);
                const f32x4 y0 = (x0[q] - mean) * rstd * g0 + b0, y1 = (x1[q] - mean) * rstd * g1 + b1;
                u32x4 o; o.x = pk2(y0[0], y0[1]); o.y = pk2(y0[2], y0[3]); o.z = pk2(y1[0], y1[1]); o.w = pk2(y1[2], y1[3]);
                *(LAS u32x4*)(lds + row * 1024 + ((lane ^ ((row & 3) << 2)) << 4)) = o; }
        }
    }
    __syncthreads();
    {
        const int g = wid, r32 = lane & 31, h8 = lane >> 5;
        const bf16* Wg = WSP + (size_t)g * 128 * 128;
#pragma unroll
        for (int tb = 0; tb < 4; ++tb) {
            f32x16 acc[2];
#pragma unroll
            for (int eb = 0; eb < 2; ++eb)
#pragma unroll
                for (int r = 0; r < 16; ++r) acc[eb][r] = 0.f;
            const int t = 32 * tb + r32; const bf16* up = UV + (tok0 + t) * 1024 + 64 * g; bf16* yp = YA + (tok0 + t) * 512 + 64 * g;
            u32x4 uq[4];
#pragma unroll
            for (int q = 0; q < 4; ++q) uq[q] = *(const u32x4*)(up + 16 * q + 8 * h8);
            const int nks = 2 * (tb + 1);
            bf16x8 wfv[8];
#pragma unroll
            for (int ks = 0; ks < 8; ++ks) if (ks < nks) wfv[ks] = *(const bf16x8*)(Wg + (size_t)(32 * tb + r32) * 128 + 16 * ks + 8 * h8);
#pragma unroll
            for (int ks = 0; ks < 8; ++ks) { if (ks >= nks) break;
                const bf16x8 wf = wfv[ks];
#pragma unroll
                for (int eb = 0; eb < 2; ++eb) {
                    const int q = (lane >> 2) & 3; const int ch = 8 * g + 4 * eb + 2 * ((lane >> 4) & 1) + ((lane & 3) >> 1);
                    const int srow = 16 * ks + 8 * h8 + q;
                    const LAS unsigned char* p0 = lds + srow * 1024 + ((ch ^ (q << 2)) << 4) + 8 * (lane & 1);
                    const s16x4 lo = vtr(p0), hi = vtr(p0 + 4 * 1024);
                    const bf16x8 vf = __builtin_shufflevector(lo, hi, 0, 1, 2, 3, 4, 5, 6, 7);
                    acc[eb] = MFMA32(vf, wf, acc[eb]);
                }
            }
            const float bias = bs[g * 128 + t];
#pragma unroll
            for (int eb = 0; eb < 2; ++eb)
#pragma unroll
                for (int k = 0; k < 2; ++k) {
                    const u32x4 uw4 = uq[2 * eb + k];
                    const auto s0 = __builtin_amdgcn_permlane32_swap(uw4.x, uw4.z, false, false), s1 = __builtin_amdgcn_permlane32_swap(uw4.y, uw4.w, false, false);
                    const unsigned ua_x = s0[0], ua_y = s1[0], ub_x = s0[1], ub_y = s1[1];
                    u32x2 oa, ob;
                    { const int g4 = 2 * k; const float f0 = acc[eb][4 * g4 + 0] + bias, f1 = acc[eb][4 * g4 + 1] + bias, f2 = acc[eb][4 * g4 + 2] + bias, f3 = acc[eb][4 * g4 + 3] + bias;
                      oa.x = pk2(bflo(ua_x) * f0, bfhi(ua_x) * f1); oa.y = pk2(bflo(ua_y) * f2, bfhi(ua_y) * f3); }
                    { const int g4 = 2 * k + 1; const float f0 = acc[eb][4 * g4 + 0] + bias, f1 = acc[eb][4 * g4 + 1] + bias, f2 = acc[eb][4 * g4 + 2] + bias, f3 = acc[eb][4 * g4 + 3] + bias;
                      ob.x = pk2(bflo(ub_x) * f0, bfhi(ub_x) * f1); ob.y = pk2(bflo(ub_y) * f2, bfhi(ub_y) * f3); }
                    const auto r0 = __builtin_amdgcn_permlane32_swap(oa.x, ob.x, false, false), r1 = __builtin_amdgcn_permlane32_swap(oa.y, ob.y, false, false);
                    u32x4 w; w.x = r0[0]; w.y = r1[0]; w.z = r0[1]; w.w = r1[1];
                    *(u32x4*)(yp + 32 * eb + 16 * k + 8 * h8) = w; }
        }
    }
    __syncthreads();
}

template <bool STORE, int VAR = 0> __device__ __forceinline__ void attn_unit(int b, int h, int qb, const bf16* Q, const bf16* K, const bf16* V, bf16* YB, LAS unsigned char* lds, float lam, const float* subln) {
    int tid_ = threadIdx.x; asm volatile("" : "+v"(tid_));
    const int tid = tid_, lane = tid & 63, wid = __builtin_amdgcn_readfirstlane(tid >> 6);
    const int m = wid >> 2, wq = wid & 3, r32 = lane & 31, h8 = lane >> 5;
    const size_t tok0 = (size_t)b * SEQ; const int q0 = qb * 128; const int qrow = q0 + 32 * wq + r32;
    constexpr int STG = 32768; constexpr float THR = 8.0f;
    bf16x8 qf[4];
    { const bf16* qp = Q + (tok0 + qrow) * 1024 + (2 * h + m) * 64 + 8 * h8;
#pragma unroll
      for (int s = 0; s < 4; ++s) qf[s] = *(const bf16x8*)(qp + 16 * s); }
    const int srow0 = tid >> 4, sch = tid & 15;
    const bf16* kg = K + (tok0 + srow0) * 1024 + h * 128 + sch * 8; const bf16* vg = V + (tok0 + srow0) * 1024 + h * 128 + sch * 8;
    unsigned kdst[2], vdst[2];
#pragma unroll
    for (int i = 0; i < 2; ++i) { const int row = srow0 + 32 * i; kdst[i] = (sch >> 3) * 8192 + row * 128 + (((sch & 7) ^ ((row >> 1) & 7)) << 4); vdst[i] = 16384 + row * 256 + ((sch ^ ((row & 3) << 2)) << 4); }
    const int nt = 2 * (qb + 1);
    u32x4 kr[2], vr[2];
#pragma unroll
    for (int t = 0; t < 2; ++t) {
#pragma unroll
        for (int i = 0; i < 2; ++i) { kr[i] = *(const u32x4*)(kg + (size_t)(64 * t + 32 * i) * 1024); vr[i] = *(const u32x4*)(vg + (size_t)(64 * t + 32 * i) * 1024); }
#pragma unroll
        for (int i = 0; i < 2; ++i) { *(LAS u32x4*)(lds + t * STG + kdst[i]) = kr[i]; *(LAS u32x4*)(lds + t * STG + vdst[i]) = vr[i]; }
    }
    __syncthreads();
    f32x16 oT[4], sT[2]; bf16x8 pf[4];
#pragma unroll
    for (int d = 0; d < 4; ++d)
#pragma unroll
        for (int r = 0; r < 16; ++r) oT[d][r] = 0.f;
#pragma unroll
    for (int s = 0; s < 4; ++s) pf[s] = (bf16x8){0, 0, 0, 0, 0, 0, 0, 0};
    float mrun = 0.f, lsum = 0.f;
    f32x16 negm;
#pragma unroll
    for (int r = 0; r < 16; ++r) negm[r] = 0.f;
    const int kq = (lane >> 2) & 3;
    const int ksw = (r32 >> 1) & 7;
    const unsigned koff = m * 8192 + r32 * 128, kc0 = ((0 + h8) ^ ksw) << 4, kc1 = ((2 + h8) ^ ksw) << 4, kc2 = ((4 + h8) ^ ksw) << 4, kc3 = ((6 + h8) ^ ksw) << 4;
    const unsigned voff = 16384 + (4 * h8 + kq) * 256 + 8 * (lane & 1); const int vch = 2 * ((lane >> 4) & 1) + ((lane & 3) >> 1);
#define SB() __builtin_amdgcn_sched_barrier(0)
#define ATT_KLD(dst, st, kb) do { const LAS unsigned char* kp_ = lds + (st) + koff + (kb) * 4096; \
        dst[0] = *(const LAS bf16x8*)(kp_ + kc0); dst[1] = *(const LAS bf16x8*)(kp_ + kc1); dst[2] = *(const LAS bf16x8*)(kp_ + kc2); dst[3] = *(const LAS bf16x8*)(kp_ + kc3); } while (0)
#define ATT_VLD(lo, hi, st, d) do { const LAS unsigned char* vp_ = lds + (st) + voff + ((((4 * (d)) + vch) ^ (kq << 2)) << 4); \
        _Pragma("unroll") for (int s = 0; s < 4; ++s) { lo[s] = vtr(vp_ + (16 * s) * 256); hi[s] = vtr(vp_ + (16 * s + 8) * 256); } } while (0)
#define ATT_VF(lo, hi, s) __builtin_shufflevector(lo[s], hi[s], 0, 1, 2, 3, 4, 5, 6, 7)
#define ATT_MMA(stv, sts, DO_S) do { \
        bf16x8 kfa_[4], kfb_[4]; s16x4 vla_[4], vha_[4], vlb_[4], vhb_[4]; \
        __builtin_amdgcn_s_setprio(1); \
        if (DO_S) { ATT_KLD(kfa_, sts, 0); } ATT_VLD(vla_, vha_, stv, 0); SB(); \
        if (DO_S) { ATT_KLD(kfb_, sts, 1); \
            sT[0] = MFMA32(kfa_[0], qf[0], negm); \
            _Pragma("unroll") for (int s = 1; s < 4; ++s) sT[0] = MFMA32(kfa_[s], qf[s], sT[0]); SB(); \
            sT[1] = MFMA32(kfb_[0], qf[0], negm); \
            _Pragma("unroll") for (int s = 1; s < 4; ++s) sT[1] = MFMA32(kfb_[s], qf[s], sT[1]); SB(); } \
        ATT_VLD(vlb_, vhb_, stv, 1); \
        _Pragma("unroll") for (int s = 0; s < 4; ++s) oT[0] = MFMA32(ATT_VF(vla_, vha_, s), pf[s], oT[0]); SB(); \
        ATT_VLD(vla_, vha_, stv, 2); \
        _Pragma("unroll") for (int s = 0; s < 4; ++s) oT[1] = MFMA32(ATT_VF(vlb_, vhb_, s), pf[s], oT[1]); SB(); \
        ATT_VLD(vlb_, vhb_, stv, 3); \
        _Pragma("unroll") for (int s = 0; s < 4; ++s) oT[2] = MFMA32(ATT_VF(vla_, vha_, s), pf[s], oT[2]); SB(); \
        _Pragma("unroll") for (int s = 0; s < 4; ++s) oT[3] = MFMA32(ATT_VF(vlb_, vhb_, s), pf[s], oT[3]); __builtin_amdgcn_s_setprio(0); SB(); } while (0)
#define MAX3(a, b, c) ({ float r_; asm("v_max3_f32 %0, %1, %2, %3" : "=v"(r_) : "v"(a), "v"(b), "v"(c)); r_; })
#define ATT_SOFTMAX(j) do { \
        if ((j) >= nt - 2) { \
            _Pragma("unroll") for (int kb = 0; kb < 2; ++kb) \
            _Pragma("unroll") for (int r = 0; r < 16; ++r) { const int kv_ = 64 * (j) + 32 * kb + crow(r, h8); if (kv_ > qrow) sT[kb][r] = -INFINITY; } } \
        float ta_ = MAX3(sT[0][0], sT[0][1], sT[0][2]), tb_ = MAX3(sT[1][0], sT[1][1], sT[1][2]); \
        _Pragma("unroll") for (int r = 3; r < 15; r += 2) { ta_ = MAX3(ta_, sT[0][r], sT[0][r + 1]); tb_ = MAX3(tb_, sT[1][r], sT[1][r + 1]); } \
        float tmax_ = MAX3(ta_, tb_, sT[0][15]); tmax_ = MAX3(tmax_, sT[1][15], sT[1][15]); \
        { auto rr_ = __builtin_amdgcn_permlane32_swap(__float_as_uint(tmax_), __float_as_uint(tmax_), false, false); tmax_ = MAX3(__uint_as_float(rr_[0]), __uint_as_float(rr_[1]), __uint_as_float(rr_[1])); } \
        if ((j) == 0 || __any(tmax_ > THR)) { const float dl_ = ((j) == 0) ? tmax_ : fmaxf(tmax_, 0.f); mrun += dl_; const float al_ = __builtin_amdgcn_exp2f(-dl_); lsum *= al_; \
            _Pragma("unroll") for (int d = 0; d < 4; ++d) _Pragma("unroll") for (int r = 0; r < 16; ++r) oT[d][r] *= al_; \
            _Pragma("unroll") for (int kb = 0; kb < 2; ++kb) _Pragma("unroll") for (int r = 0; r < 16; ++r) sT[kb][r] -= dl_; \
            _Pragma("unroll") for (int r = 0; r < 16; ++r) negm[r] = -mrun; } \
        _Pragma("unroll") for (int kb = 0; kb < 2; ++kb) \
        _Pragma("unroll") for (int r = 0; r < 16; ++r) sT[kb][r] = __builtin_amdgcn_exp2f(sT[kb][r]); \
        float p0_ = sT[0][0] + sT[0][1], p1_ = sT[0][2] + sT[0][3], p2_ = sT[1][0] + sT[1][1], p3_ = sT[1][2] + sT[1][3]; \
        _Pragma("unroll") for (int r = 4; r < 16; r += 4) { p0_ += sT[0][r]; p1_ += sT[0][r + 2]; p2_ += sT[1][r]; p3_ += sT[1][r + 2]; p0_ += sT[0][r + 1]; p1_ += sT[0][r + 3]; p2_ += sT[1][r + 1]; p3_ += sT[1][r + 3]; } \
        lsum += (p0_ + p1_) + (p2_ + p3_); \
        _Pragma("unroll") for (int s = 0; s < 4; ++s) { u32x4 w_; \
            w_.x = pg8::cvt_pk_bf16(sT[s >> 1][8 * (s & 1) + 0], sT[s >> 1][8 * (s & 1) + 1]); w_.y = pg8::cvt_pk_bf16(sT[s >> 1][8 * (s & 1) + 2], sT[s >> 1][8 * (s & 1) + 3]); \
            w_.z = pg8::cvt_pk_bf16(sT[s >> 1][8 * (s & 1) + 4], sT[s >> 1][8 * (s & 1) + 5]); w_.w = pg8::cvt_pk_bf16(sT[s >> 1][8 * (s & 1) + 6], sT[s >> 1][8 * (s & 1) + 7]); \
            pf[s] = __builtin_bit_cast(bf16x8, w_); } } while (0)
    if (m == 1) __builtin_amdgcn_s_barrier();
    int stV = 0, stS = 0, stW = 2 * STG;
    for (int it = 0; it < nt; ++it) {
        const bool ld = (it + 2 < nt);
        if (ld) {
#pragma unroll
            for (int i = 0; i < 2; ++i) { kr[i] = *(const u32x4*)(kg + (size_t)(64 * (it + 2) + 32 * i) * 1024); vr[i] = *(const u32x4*)(vg + (size_t)(64 * (it + 2) + 32 * i) * 1024); }
        }
        if (VAR != 2 && VAR != 3) ATT_MMA(stV, stS, true);
        asm volatile("s_waitcnt lgkmcnt(0)" ::: "memory"); __builtin_amdgcn_s_barrier(); asm volatile("" ::: "memory");
        if (VAR != 1 && VAR != 3) ATT_SOFTMAX(it);
        if (ld) {
#pragma unroll
            for (int i = 0; i < 2; ++i) { *(LAS u32x4*)(lds + stW + kdst[i]) = kr[i]; *(LAS u32x4*)(lds + stW + vdst[i]) = vr[i]; }
        }
        __syncthreads();
        stV = stS; stS = (stS == 3 * STG) ? 0 : stS + STG; stW = (stW == 3 * STG) ? 0 : stW + STG;
    }
    ATT_MMA(stV, stS, false);
    __syncthreads();
    __syncthreads();
    if (m == 0) __builtin_amdgcn_s_barrier();
#undef ATT_MMA
#undef ATT_KLD
#undef ATT_VLD
#undef ATT_VF
#undef SB
#undef ATT_SOFTMAX
#undef MAX3
    { auto rr = __builtin_amdgcn_permlane32_swap(__float_as_uint(lsum), __float_as_uint(lsum), false, false); lsum = __uint_as_float(rr[0]) + __uint_as_float(rr[1]); }
    const float inv = 1.0f / lsum;
    LAS float* cmb = (LAS float*)lds + wq * 4096;
    if (m == 1) {
#pragma unroll
        for (int d = 0; d < 4; ++d)
#pragma unroll
            for (int r4 = 0; r4 < 4; ++r4) *(LAS f32x4*)(cmb + ((d * 4 + r4) * 64 + lane) * 4) = (f32x4){oT[d][4 * r4] * inv, oT[d][4 * r4 + 1] * inv, oT[d][4 * r4 + 2] * inv, oT[d][4 * r4 + 3] * inv};
    }
    __syncthreads();
    if (m == 0) {
        float sq = 0.f;
#pragma unroll
        for (int d = 0; d < 4; ++d)
#pragma unroll
            for (int r4 = 0; r4 < 4; ++r4) { const f32x4 c4 = *(const LAS f32x4*)(cmb + ((d * 4 + r4) * 64 + lane) * 4);
#pragma unroll
                for (int i = 0; i < 4; ++i) { const float y = oT[d][4 * r4 + i] * inv - lam * c4[i]; oT[d][4 * r4 + i] = y; sq += y * y; } }
        { auto rr = __builtin_amdgcn_permlane32_swap(__float_as_uint(sq), __float_as_uint(sq), false, false); sq = __uint_as_float(rr[0]) + __uint_as_float(rr[1]); }
        const float rn = __builtin_amdgcn_rsqf(sq * (1.0f / 128.0f) + 1e-6f) * (1.0f - LAM_INIT);
        bf16* yp = YB + (tok0 + qrow) * 1024 + h * 128;
#pragma unroll
        for (int d = 0; d < 4; ++d)
#pragma unroll
            for (int k = 0; k < 2; ++k) { u32x2 oa, ob;
                { const int g4 = 2 * k, d0 = 32 * d + 8 * g4 + 4 * h8; const f32x4 sg = *(const f32x4*)(subln + d0);
                  oa.x = pk2(oT[d][4 * g4 + 0] * rn * sg[0], oT[d][4 * g4 + 1] * rn * sg[1]); oa.y = pk2(oT[d][4 * g4 + 2] * rn * sg[2], oT[d][4 * g4 + 3] * rn * sg[3]); }
                { const int g4 = 2 * k + 1, d0 = 32 * d + 8 * g4 + 4 * h8; const f32x4 sg = *(const f32x4*)(subln + d0);
                  ob.x = pk2(oT[d][4 * g4 + 0] * rn * sg[0], oT[d][4 * g4 + 1] * rn * sg[1]); ob.y = pk2(oT[d][4 * g4 + 2] * rn * sg[2], oT[d][4 * g4 + 3] * rn * sg[3]); }
                const auto r0 = __builtin_amdgcn_permlane32_swap(oa.x, ob.x, false, false), r1 = __builtin_amdgcn_permlane32_swap(oa.y, ob.y, false, false);
                u32x4 w; w.x = r0[0]; w.y = r1[0]; w.z = r0[1]; w.w = r1[1];
                if (STORE) *(u32x4*)(yp + 32 * d + 16 * k + 8 * h8) = w; else if (w.x == 0x12345678u && w.y == 0x9abcdef0u) *(u32x4*)(yp + 32 * d + 16 * k + 8 * h8) = w; }
    }
    __syncthreads();
}

__global__ void __launch_bounds__(NWAVES * 64, 2) mega_fwd(Args args) {
    extern __shared__ __attribute__((aligned(16))) unsigned char lds_raw[];
    LAS unsigned char* lds = (LAS unsigned char*)lds_raw;
    const int tid = threadIdx.x, lane = tid & 63, wave = __builtin_amdgcn_readfirstlane(tid >> 6);
    const int G = gridDim.x, bx = blockIdx.x; const int vcu = (G % 8 == 0) ? (bx % 8) * (G / 8) + bx / 8 : bx;
    unsigned char* ws = args.ws;
    { LAS unsigned* misc0 = (LAS unsigned*)(lds + 131072); if (tid < 64) misc0[tid] = 0u; }
    __syncthreads();
    const XcdBarrier gbar = xcd_barrier_post((unsigned*)(ws + WS_CTL), (volatile LAS unsigned*)(lds + 131072) + 8);
    const float* x = args.in[0]; const int* positions = (const int*)args.in[1];
    const float *ffn1_norm = args.in[2], *ffn1_wg = args.in[3], *ffn1_wu = args.in[4], *ffn1_wd = args.in[5], *mix_norm = args.in[6], *w_in = args.in[7];
    const float *a_ln_g = args.in[8], *a_ln_b = args.in[9], *a_w_s = args.in[10], *a_b_s = args.in[11], *a_w_proj = args.in[12];
    const float *b_qn = args.in[13], *b_kn = args.in[14], *lq1 = args.in[15], *lk1 = args.in[16], *lq2 = args.in[17], *lk2 = args.in[18], *b_subln = args.in[19], *b_w_proj = args.in[20];
    const float *w_out = args.in[21], *ffn2_norm = args.in[22], *ffn2_wg = args.in[23], *ffn2_wu = args.in[24], *ffn2_wd = args.in[25];
    float* out = args.out;
    bf16 *W1GU = (bf16*)(ws + WS_W1GU), *W1D = (bf16*)(ws + WS_W1D), *WIN = (bf16*)(ws + WS_WIN), *WPA = (bf16*)(ws + WS_WPA), *WPB = (bf16*)(ws + WS_WPB), *WO = (bf16*)(ws + WS_WO);
    bf16 *W2GU = (bf16*)(ws + WS_W2GU), *W2D = (bf16*)(ws + WS_W2D), *WSP = (bf16*)(ws + WS_WSP);
    float *ROPE = (float*)(ws + WS_ROPE), *SS = (float*)(ws + WS_SS);
    bf16 *XB = (bf16*)(ws + WS_XB), *YA = (bf16*)(ws + WS_YA), *H = (bf16*)(ws + WS_H), *SG = (bf16*)(ws + WS_SG), *UV = (bf16*)(ws + WS_UV), *MM = (bf16*)(ws + WS_MM);
    bf16 *QB = (bf16*)(ws + WS_Q), *YB = (bf16*)(ws + WS_YB), *KB = (bf16*)(ws + WS_K), *VB = (bf16*)(ws + WS_V);

    for (int rep = 0; rep < NREP(0); ++rep) {
        LAS float* scr = (LAS float*)(lds + wave * 16384);
        const int gw = vcu * NWAVES + wave, NGW = G * NWAVES;
        constexpr int I_GU = 176 * 16, I_D = 32 * 44, I_IN = 192 * 16, I_PA = 32 * 8, I_PB = 32 * 16, I_WO = 32 * 16;
        constexpr int NITEMS = 2 * I_GU + 2 * I_D + I_IN + I_PA + I_PB + I_WO;
        for (int it = gw; it < NITEMS; it += NGW) {
            int r = it;
            if (r < I_GU) { conv_gu(ffn1_wg, ffn1_wu, ffn1_norm, W1GU, scr, r, lane); continue; } r -= I_GU;
            if (r < I_GU) { conv_gu(ffn2_wg, ffn2_wu, ffn2_norm, W2GU, scr, r, lane); continue; } r -= I_GU;
            if (r < I_IN) { conv_win(w_in, mix_norm, WIN, scr, r, lane); continue; } r -= I_IN;
            if (r < I_D) { conv_item(ffn1_wd, DM, DFF, 32 * (r / 44), W1D, 32 * (r / 44), false, nullptr, scr, r % 44, lane); continue; } r -= I_D;
            if (r < I_D) { conv_item(ffn2_wd, DM, DFF, 32 * (r / 44), W2D, 32 * (r / 44), false, nullptr, scr, r % 44, lane); continue; } r -= I_D;
            if (r < I_PA) { conv_item(a_w_proj, DM, AW, 32 * (r >> 3), WPA, 32 * (r >> 3), false, nullptr, scr, r & 7, lane); continue; } r -= I_PA;
            if (r < I_PB) { conv_item(b_w_proj, DM, DM, 32 * (r >> 4), WPB, 32 * (r >> 4), false, nullptr, scr, r & 15, lane); continue; } r -= I_PB;
            conv_item(w_out, DM, DM, 32 * (r >> 4), WO, 32 * (r >> 4), false, nullptr, scr, r & 15, lane);
        }
        const int gt = vcu * (NWAVES * 64) + tid, NGT = G * NWAVES * 64;
        for (int i = gt; i < 8 * 128 * 128; i += NGT) { const int s = i & 127, t = (i >> 7) & 127; WSP[i] = (bf16)f2bf(s <= t ? a_w_s[i] : 0.f); }
        for (int i = gt; i < MT * 8; i += NGT) { const int row = i >> 3, j = i & 7;
            const float inv = (j == 0) ? 1.0f : exp2f(-(float)j * 0.125f * 18.931568569324174f);
            const float ang = (float)positions[row] * inv;
            ROPE[(size_t)row * 16 + j] = cosf(ang); ROPE[(size_t)row * 16 + 8 + j] = sinf(ang); }
        for (int row0 = gw; row0 < MT; row0 += 4 * NGW) {
            f32x4 v[4][4];
#pragma unroll
            for (int q = 0; q < 4; ++q) { const int row = row0 + q * NGW; const f32x4* xr = (const f32x4*)(x + (size_t)(row < MT ? row : row0) * DM) + lane;
#pragma unroll
                for (int j = 0; j < 4; ++j) v[q][j] = __builtin_nontemporal_load(xr + 64 * j); }
#pragma unroll
            for (int q = 0; q < 4; ++q) { const int row = row0 + q * NGW; if (row >= MT) break; float sq = 0.f;
                unsigned long long* o8 = (unsigned long long*)(XB + (size_t)row * DM) + lane;
#pragma unroll
                for (int j = 0; j < 4; ++j) { const f32x4 t = v[q][j]; sq += (t[0] * t[0] + t[1] * t[1]) + (t[2] * t[2] + t[3] * t[3]);
                    o8[64 * j] = (unsigned long long)pk2(t[0], t[1]) | ((unsigned long long)pk2(t[2], t[3]) << 32); }
                sq = wave_sum(sq);
                if (lane < 16) SS[(size_t)row * 16 + lane] = (lane == 0) ? sq : 0.f; }
        }
    }
    xcd_barrier(gbar);
    if (REP_MASK & 256) { for (int i = 0; i < 8; ++i) xcd_barrier(gbar); }
    if (REP_MASK & 512) { pg8::Gemm g{XB, W1GU, MT, 2 * DFF, DM}; pg8::StaticOrder S; S.init(MT, 2 * DFF, G, bx);
      pg8::EpiPlainH E{H, DFF};
      pg8::gemm_phase<pg8::EpiPlainH, pg8::StaticOrder, true, true>(lds, g, S, E); xcd_barrier(gbar); }
    for (int rep = 0; rep < NREP(1); ++rep) { if (rep) xcd_barrier(gbar); pg8::Gemm g{XB, W1GU, MT, 2 * DFF, DM}; pg8::StaticOrder S; S.init(MT, 2 * DFF, G, bx);
      pg8::rs_tags_clear(lds); pg8::EpiSwiglu E{H, SS, DFF, lds};
      pg8::gemm_phase<pg8::EpiSwiglu, pg8::StaticOrder, true, true>(lds, g, S, E); }
    xcd_barrier(gbar);
    for (int rep = 0; rep < NREP(2); ++rep) { if (rep) xcd_barrier(gbar); pg8::Gemm g{H, W1D, MT, DM, DFF}; pg8::StaticOrder S; S.init(MT, DM, G, bx);
      pg8::EpiResid<true> E{x, out, XB, SS, 0.5f};
      pg8::gemm_phase<pg8::EpiResid<true>, pg8::StaticOrder, true, true>(lds, g, S, E); }
    xcd_barrier(gbar);
    for (int rep = 0; rep < NREP(3); ++rep) { if (rep) xcd_barrier(gbar); pg8::Gemm g{XB, WIN, MT, INC, DM}; pg8::StaticOrder S; S.init(MT, INC, G, bx);
      pg8::rs_tags_clear(lds); pg8::EpiWin E{SS, SG, UV, QB, KB, VB, ROPE, b_qn, b_kn, QSCALE, lds};
      pg8::gemm_phase<pg8::EpiWin, pg8::StaticOrder, true, true>(lds, g, S, E); }
    xcd_barrier(gbar);
    {
        for (int rep = 0; rep < NREP(5); ++rep) for (int c = vcu; c < MT / 128; c += G) gmlp_unit(c, UV, WSP, a_ln_g, a_ln_b, a_b_s, YA, lds);
        float d1 = lq1[lane] * lk1[lane], d2 = lq2[lane] * lk2[lane];
        d1 = wave_sum(d1); d2 = wave_sum(d2);
        const float lam = expf(d1) - expf(d2) + LAM_INIT;
        for (int slot = vcu; slot < BATCH * NH * 4; slot += G) { const int bh = slot >> 2, sub = slot & 3;
            for (int rep = 0; rep < NREP(4); ++rep)
            for (int r = 0; r < 8; ++r) { const int rp = (r & 1) ? (r >> 1) : 7 - (r >> 1); const int qb = 4 * rp + ((sub + r) & 3);
                if (rep + 1 < NREP(4)) attn_unit<false, ATT_VAR>(bh >> 3, bh & 7, qb, QB, KB, VB, YB, lds, lam, b_subln);
                else attn_unit<true>(bh >> 3, bh & 7, qb, QB, KB, VB, YB, lds, lam, b_subln); } }
    }
    xcd_barrier(gbar);
    { pg8::Gemm g{YA, WPA, MT, DM, AW}; pg8::StaticOrder S; S.init(MT, DM, G, bx);
      pg8::EpiGate<true> E{SG, 0, MM};
      pg8::gemm_phase<pg8::EpiGate<true>, pg8::StaticOrder, true, true>(lds, g, S, E); }
    __syncthreads();
    { pg8::Gemm g{YB, WPB, MT, DM, DM}; pg8::StaticOrder S; S.init(MT, DM, G, bx);
      pg8::EpiGate<false> E{SG, 1024, MM};
      pg8::gemm_phase<pg8::EpiGate<false>, pg8::StaticOrder, true, true>(lds, g, S, E); }
    xcd_barrier(gbar);
    { pg8::Gemm g{MM, WO, MT, DM, DM}; pg8::StaticOrder S; S.init(MT, DM, G, bx);
      pg8::EpiResid<true> E{out, out, XB, SS, 1.0f};
      pg8::gemm_phase<pg8::EpiResid<true>, pg8::StaticOrder, true, true>(lds, g, S, E); }
    xcd_barrier(gbar);
    for (int rep = 0; rep < NREP(7); ++rep) { if (rep) xcd_barrier(gbar); pg8::Gemm g{XB, W2GU, MT, 2 * DFF, DM}; pg8::StaticOrder S; S.init(MT, 2 * DFF, G, bx);
      pg8::rs_tags_clear(lds); pg8::EpiSwiglu E{H, SS, DFF, lds};
      pg8::gemm_phase<pg8::EpiSwiglu, pg8::StaticOrder, true, true>(lds, g, S, E); }
    xcd_barrier(gbar);
    { pg8::Gemm g{H, W2D, MT, DM, DFF}; pg8::StaticOrder S; S.init(MT, DM, G, bx);
      pg8::EpiResid<false> E{out, out, nullptr, nullptr, 0.5f};
      pg8::gemm_phase<pg8::EpiResid<false>, pg8::StaticOrder, true, true>(lds, g, S, E); }
}

extern "C" void kernel_launch(void* const* d_in, const int* in_sizes, int n_in, void* d_out, int out_size, void* d_ws, size_t ws_size, hipStream_t stream) {
    static int grid = 0;
    if (grid == 0) {
        if (n_in != 26 || in_sizes[0] != MT * DM || out_size != MT * DM || ws_size < WS_END) { fprintf(stderr, "kernel_launch: unexpected shapes (n_in %d, in0 %d, out %d, ws %zu); nothing launched\n", n_in, n_in > 0 ? in_sizes[0] : -1, out_size, ws_size); grid = -1; return; }
        int dev = 0, cus = 0, per_cu = 0;
        if (hipGetDevice(&dev) != hipSuccess || hipDeviceGetAttribute(&cus, hipDeviceAttributeMultiprocessorCount, dev) != hipSuccess) { grid = -1; return; }
        if (hipFuncSetAttribute((const void*)mega_fwd, hipFuncAttributeMaxDynamicSharedMemorySize, LDS_BYTES) != hipSuccess) { fprintf(stderr, "kernel_launch: hipFuncSetAttribute failed\n"); grid = -1; return; }
        if (hipOccupancyMaxActiveBlocksPerMultiprocessor(&per_cu, (const void*)mega_fwd, NWAVES * 64, LDS_BYTES) != hipSuccess || per_cu < 1) { fprintf(stderr, "kernel_launch: occupancy query says %d blocks per CU\n", per_cu); (void)hipGetLastError(); grid = -1; return; }
        grid = cus;
    }
    if (grid < 0) return;
    if (hipMemsetAsync((char*)d_ws + WS_CTL, 0, CTL_ZERO_BYTES, stream) != hipSuccess) { fprintf(stderr, "kernel_launch: memset of the barrier words failed\n"); return; }
    Args a{};
    for (int i = 0; i < 26; ++i) a.in[i] = (const float*)d_in[i];
    a.out = (float*)d_out; a.ws = (unsigned char*)d_ws;
    void* kargs[] = {&a};
    hipError_t e = hipLaunchCooperativeKernel((const void*)mega_fwd, dim3(grid), dim3(NWAVES * 64), kargs, LDS_BYTES, stream);
    if (e != hipSuccess) fprintf(stderr, "kernel_launch: cooperative launch failed: %s (grid %d)\n", hipGetErrorString(e), grid);
}
```

```cpp
#include <hip/hip_runtime.h>
#include <hip/hip_cooperative_groups.h>
#include <cstdio>
#include <cstdint>
namespace cg = cooperative_groups;
namespace pg8 {
#define PG8_LAS __attribute__((address_space(3)))
typedef unsigned short bf16_t;
typedef short bf16x8 __attribute__((ext_vector_type(8)));
typedef float f32x4 __attribute__((ext_vector_type(4)));
typedef unsigned u32x4 __attribute__((ext_vector_type(4)));
constexpr int BM = 256, BK = 64, HALF = 128, HTB = HALF * BK * 2  , STAGE_BYTES = 8 * HTB, NXCD = 8, WGM = 8;

__host__ __device__ __forceinline__ int lds_byte(int r, int c) { const int st = (r >> 4) * 2 + (c >> 5), rr = r & 15, cc = c & 31, ob = rr * 64 + cc * 2; return st * 1024 + (ob ^ (((ob >> 9) & 1) << 5)); }
__host__ __device__ __forceinline__ void stage_rc(int b, int& R, int& C) { const int st = b / 1024, sb = b % 1024, swz = sb ^ (((sb >> 9) & 1) << 5); R = (st >> 1) * 16 + swz / 64; C = (st & 1) * 32 + (swz % 64) / 2; }
__host__ __device__ __forceinline__ int perm32(int rho) { const int n = rho >> 4, i = rho & 15; return 8 * (i >> 2) + 4 * n + (i & 3); }

struct Unit { int pm, pn; };
struct Gemm { const bf16_t* A; const bf16_t* Bt; int M, N, K; };

struct StaticOrder {
    int nM, nN, nwg, G, c;
    __host__ __device__ void init(int M, int N, int G_, int c_) { nM = M / BM; nN = N / BM; nwg = nM * nN; G = G_; c = c_; }
    __host__ __device__ bool next(int i, Unit& u) const {
        const long L = (long)i * G + c; if (L >= nwg) return false;
        int wgid = (int)L; { const int q = nwg / NXCD, r = nwg % NXCD, xcd = wgid % NXCD, off = wgid / NXCD; wgid = (xcd < r ? xcd * (q + 1) : r * (q + 1) + (xcd - r) * q) + off; }
        const int nig = WGM * nN, gid = wgid / nig, fm = gid * WGM, gsz = (nM - fm) < WGM ? (nM - fm) : WGM;
        u.pm = fm + ((wgid % nig) % gsz); u.pn = (wgid % nig) / gsz; return true;
    }
    __device__ __forceinline__ void a_ready(const Unit&) const {}
    __device__ __forceinline__ void done(const Unit&) const {}
};

__device__ __forceinline__ unsigned cvt_pk_bf16(float lo, float hi) { unsigned r; asm volatile("v_cvt_pk_bf16_f32 %0, %1, %2" : "=v"(r) : "v"(lo), "v"(hi)); return r; }
typedef float f32x2 __attribute__((ext_vector_type(2)));
__device__ __forceinline__ f32x2 gelu_pk(f32x2 v) {
    const f32x2 av = __builtin_elementwise_abs(v), d = av * 0.2316418882f + 1.0f;
    f32x2 t; t.x = __builtin_amdgcn_rcpf(d.x); t.y = __builtin_amdgcn_rcpf(d.y);
    f32x2 q = t * 0.5307027145f + (-0.7265760135f); q = q * t + 0.7107068705f; q = q * t + (-0.142248368f); q = q * t + 0.127414796f; q = q * t;
    const f32x2 s = (v * v) * (-0.72134752044f);
    f32x2 e; e.x = __builtin_amdgcn_exp2f(s.x); e.y = __builtin_amdgcn_exp2f(s.y);
    const f32x2 m = v * (q * e), r = v - m;
    f32x2 o; o.x = v.x < 0.f ? m.x : r.x; o.y = v.y < 0.f ? m.y : r.y; return o;
}
__device__ __forceinline__ f32x4 gelu4(f32x4 v) { f32x2 a = gelu_pk((f32x2){v[0], v[1]}), b = gelu_pk((f32x2){v[2], v[3]}); return (f32x4){a.x, a.y, b.x, b.y}; }
__device__ __forceinline__ float sigm1(float x) { return __builtin_amdgcn_rcpf(1.0f + __builtin_amdgcn_exp2f(-1.4426950408889634f * x)); }
__device__ __forceinline__ f32x4 sigm4(f32x4 v) { return (f32x4){sigm1(v[0]), sigm1(v[1]), sigm1(v[2]), sigm1(v[3])}; }
__device__ __forceinline__ u32x4 pack8(f32x4 a, f32x4 b) { u32x4 w; w.x = cvt_pk_bf16(a[0], a[1]); w.y = cvt_pk_bf16(a[2], a[3]); w.z = cvt_pk_bf16(b[0], b[1]); w.w = cvt_pk_bf16(b[2], b[3]); return w; }
__device__ __forceinline__ void unpack8(u32x4 w, f32x4& a, f32x4& b) {
    a = (f32x4){__uint_as_float(w.x << 16), __uint_as_float(w.x & 0xffff0000u), __uint_as_float(w.y << 16), __uint_as_float(w.y & 0xffff0000u)};
    b = (f32x4){__uint_as_float(w.z << 16), __uint_as_float(w.z & 0xffff0000u), __uint_as_float(w.w << 16), __uint_as_float(w.w & 0xffff0000u)}; }
constexpr int SSN = 16;
__device__ __forceinline__ float row_rstd(const float* ss, int row) {
    const f32x4* p = (const f32x4*)(ss + (size_t)row * SSN); const f32x4 a = p[0], b = p[1], c = p[2], d = p[3];
    const f32x4 s = (a + b) + (c + d); const float t = (s[0] + s[1]) + (s[2] + s[3]);
    return __builtin_amdgcn_rsqf(t * (1.0f / 1024.0f) + 1e-6f);
}

__device__ __forceinline__ void rstd8(const float* ss, int row0, int fq, float (&rs)[2][4]) {
    f32x4 t[2][4];
#pragma unroll
    for (int ai = 0; ai < 2; ++ai)
#pragma unroll
        for (int m = 0; m < 4; ++m) t[ai][m] = *(const f32x4*)(ss + (size_t)(row0 + ai * HALF + m * 16) * SSN + 4 * fq);
#pragma unroll
    for (int ai = 0; ai < 2; ++ai)
#pragma unroll
        for (int m = 0; m < 4; ++m) { float v = (t[ai][m][0] + t[ai][m][1]) + (t[ai][m][2] + t[ai][m][3]); v += __shfl_xor(v, 16); v += __shfl_xor(v, 32);
            rs[ai][m] = __builtin_amdgcn_rsqf(v * (1.0f / 1024.0f) + 1e-6f); }
}
typedef PG8_LAS float* rs_tab_t;
constexpr int RS_TAB_OFF = 131072 + 1024, RS_TAG_OFF = 131072 + 1024 + 4096;
__device__ __forceinline__ void rs_tags_clear(PG8_LAS unsigned char* lds) { if (threadIdx.x < 8) ((PG8_LAS int*)(lds + RS_TAG_OFF))[threadIdx.x] = -1; asm volatile("s_waitcnt lgkmcnt(0)" ::: "memory"); __builtin_amdgcn_s_barrier(); }
__device__ __forceinline__ void rs_cached(PG8_LAS unsigned char* lds, const float* ss, const Unit& u, int wr, int wc, int fr, int fq, float (&rs)[2][4]) {
    const int wid = wr * 4 + wc; rs_tab_t tab = (rs_tab_t)(lds + RS_TAB_OFF) + wid * 128; PG8_LAS int* tagp = (PG8_LAS int*)(lds + RS_TAG_OFF) + wid;
    const int tag = __builtin_amdgcn_readfirstlane(*tagp);
    if (tag != u.pm) {
        rstd8(ss, u.pm * BM + wr * 64 + fr, fq, rs);
        if (fq == 0) {
#pragma unroll
            for (int ai = 0; ai < 2; ++ai)
#pragma unroll
                for (int m = 0; m < 4; ++m) tab[ai * 64 + m * 16 + fr] = rs[ai][m];
        }
        if (fr == 0 && fq == 0) *tagp = u.pm;
    } else {
#pragma unroll
        for (int ai = 0; ai < 2; ++ai)
#pragma unroll
            for (int m = 0; m < 4; ++m) rs[ai][m] = tab[ai * 64 + m * 16 + fr];
    }
}
struct EpiSwiglu {
    static constexpr bool PERM = true, AFTER_DRAIN = false;
    bf16_t* H; const float* ss; int ldh; PG8_LAS unsigned char* lds;
    __device__ __forceinline__ void operator()(const f32x4 (&acc)[2][2][4][2], const Unit& u, int wr, int wc, int fr, int fq) const {
        const int row0 = u.pm * BM + wr * 64 + fr, col0 = u.pn * HALF + wc * 32 + 8 * fq;
        float rsv[2][4]; rs_cached(lds, ss, u, wr, wc, fr, fq, rsv);
#pragma unroll
        for (int ai = 0; ai < 2; ++ai)
#pragma unroll
            for (int m = 0; m < 4; ++m) { const int row = row0 + ai * HALF + m * 16; const float rs = rsv[ai][m]; const float c1 = -1.4426950408889634f * rs, c2 = rs * rs;
                f32x4 o[2];
#pragma unroll
                for (int n = 0; n < 2; ++n) {
                    const f32x4 ga = acc[ai][0][m][n], t = ga * c1; f32x4 sg;
#pragma unroll
                    for (int i = 0; i < 4; ++i) sg[i] = __builtin_amdgcn_rcpf(1.0f + __builtin_amdgcn_exp2f(t[i]));
                    o[n] = (ga * acc[ai][1][m][n]) * (sg * c2); }
                *(u32x4*)(H + (size_t)row * ldh + col0) = pack8(o[0], o[1]); }
    }
};
template <bool WX> struct EpiResid {
    static constexpr bool PERM = true, AFTER_DRAIN = false;
    const float* base; float* out; bf16_t* XB; float* ss; float scale;
    __device__ __forceinline__ void operator()(const f32x4 (&acc)[2][2][4][2], const Unit& u, int wr, int wc, int fr, int fq) const {
        const int row0 = u.pm * BM + wr * 64 + fr, col0 = u.pn * BM + wc * 32 + 8 * fq;
#pragma unroll
        for (int ai = 0; ai < 2; ++ai) {
            f32x4 bv[4][2][2];
#pragma unroll
            for (int m = 0; m < 4; ++m)
#pragma unroll
                for (int bj = 0; bj < 2; ++bj) { const size_t off = (size_t)(row0 + ai * HALF + m * 16) * 1024 + col0 + bj * HALF; bv[m][bj][0] = *(const f32x4*)(base + off); bv[m][bj][1] = *(const f32x4*)(base + off + 4); }
#pragma unroll
            for (int m = 0; m < 4; ++m) { const int row = row0 + ai * HALF + m * 16; float sq = 0.f;
#pragma unroll
                for (int bj = 0; bj < 2; ++bj) { const size_t off = (size_t)row * 1024 + col0 + bj * HALF;
                    const f32x4 b0 = bv[m][bj][0], b1 = bv[m][bj][1];
                    const f32x4 o0 = b0 + acc[ai][bj][m][0] * scale, o1 = b1 + acc[ai][bj][m][1] * scale;
                    __builtin_nontemporal_store(o0, (f32x4*)(out + off)); __builtin_nontemporal_store(o1, (f32x4*)(out + off + 4));
                    if (WX) { *(u32x4*)(XB + off) = pack8(o0, o1);
                        sq += (o0[0] * o0[0] + o0[1] * o0[1]) + (o0[2] * o0[2] + o0[3] * o0[3]) + (o1[0] * o1[0] + o1[1] * o1[1]) + (o1[2] * o1[2] + o1[3] * o1[3]); } }
                if (WX) { sq += __shfl_xor(sq, 16); sq += __shfl_xor(sq, 32); if (fq == 0) ss[(size_t)row * SSN + u.pn * 4 + wc] = sq; } } }
    }
};
template <bool FIRST> struct EpiGate {
    static constexpr bool PERM = true, AFTER_DRAIN = false;
    const bf16_t* SG; int sgoff; bf16_t* MM;
    __device__ __forceinline__ void operator()(const f32x4 (&acc)[2][2][4][2], const Unit& u, int wr, int wc, int fr, int fq) const {
        const int row0 = u.pm * BM + wr * 64 + fr, col0 = u.pn * BM + wc * 32 + 8 * fq;
#pragma unroll
        for (int ai = 0; ai < 2; ++ai) {
            u32x4 sgv[4][2], mmv[4][2];
#pragma unroll
            for (int m = 0; m < 4; ++m)
#pragma unroll
                for (int bj = 0; bj < 2; ++bj) { const int row = row0 + ai * HALF + m * 16, col = col0 + bj * HALF; sgv[m][bj] = *(const u32x4*)(SG + (size_t)row * 2048 + sgoff + col);
                    if (!FIRST) mmv[m][bj] = *(const u32x4*)(MM + (size_t)row * 1024 + col); }
#pragma unroll
            for (int m = 0; m < 4; ++m) { const int row = row0 + ai * HALF + m * 16;
#pragma unroll
                for (int bj = 0; bj < 2; ++bj) { const int col = col0 + bj * HALF;
                    f32x4 s0, s1; unpack8(sgv[m][bj], s0, s1);
                    f32x4 o0 = s0 * acc[ai][bj][m][0], o1 = s1 * acc[ai][bj][m][1];
                    bf16_t* mp = MM + (size_t)row * 1024 + col;
                    if (!FIRST) { f32x4 p0, p1; unpack8(mmv[m][bj], p0, p1); o0 += p0; o1 += p1; }
                    *(u32x4*)mp = pack8(o0, o1); } } }
    }
};
struct EpiWin {
    static constexpr bool PERM = true, AFTER_DRAIN = false;
    const float* ss; bf16_t *SG, *UV, *QB, *KB, *VB; const float* rope; const float *qg, *kg; float qscale; PG8_LAS unsigned char* lds;
    __device__ __forceinline__ void operator()(const f32x4 (&acc)[2][2][4][2], const Unit& u, int wr, int wc, int fr, int fq) const {
        const int row0 = u.pm * BM + wr * 64 + fr; const int typ = u.pn >> 2;
        float rsv[2][4]; rs_cached(lds, ss, u, wr, wc, fr, fq, rsv);
        if (typ == 3 || typ == 4) {
            const float* gp = (typ == 3) ? qg : kg; bf16_t* dst = (typ == 3) ? QB : KB; const float osc = (typ == 3) ? qscale : 1.0f;
            const int grp = 4 * (u.pn & 3) + wc;
            f32x4 gn[2][2];
            gn[0][0] = *(const f32x4*)(gp + (fq < 2 ? 4 * fq : 8 * fq)); gn[0][1] = *(const f32x4*)(gp + (fq < 2 ? 8 + 4 * fq : 8 * fq + 4));
            gn[1][0] = *(const f32x4*)(gp + 32 + 8 * fq); gn[1][1] = *(const f32x4*)(gp + 32 + 8 * fq + 4);
#pragma unroll
            for (int bj = 0; bj < 2; ++bj)
#pragma unroll
                for (int n = 0; n < 2; ++n) gn[bj][n] = gn[bj][n] * osc;
#pragma unroll
            for (int ai = 0; ai < 4; ++ai) {
                f32x4 csv[2], snv[2];
#pragma unroll
                for (int m = 0; m < 2; ++m) { const float* rp = rope + (size_t)(row0 + (ai >> 1) * HALF + ((ai & 1) * 2 + m) * 16) * 16 + 4 * (fq & 1); csv[m] = *(const f32x4*)rp; snv[m] = *(const f32x4*)(rp + 8); }
#pragma unroll
                for (int m = 0; m < 2; ++m) { const int AI = ai >> 1, M = (ai & 1) * 2 + m; const int row = row0 + AI * HALF + M * 16;
                    f32x4 v[2][2]; float sq = 0.f;
#pragma unroll
                    for (int bj = 0; bj < 2; ++bj)
#pragma unroll
                        for (int n = 0; n < 2; ++n) { v[bj][n] = acc[AI][bj][M][n]; const f32x4 x = v[bj][n]; sq += (x[0] * x[0] + x[1] * x[1]) + (x[2] * x[2] + x[3] * x[3]); }
                    sq += __shfl_xor(sq, 16); sq += __shfl_xor(sq, 32);
                    const float rs = rsv[AI][M]; const float rn = rs * __builtin_amdgcn_rsqf(rs * rs * sq * (1.0f / 64.0f) + 1e-6f);
                    const f32x4 cs = csv[m], sn = snv[m];
                    f32x4 r1 = v[0][0] * rn * gn[0][0], r2 = v[0][1] * rn * gn[0][1];
                    if (fq < 2) { const f32x4 a = r1 * cs - r2 * sn, b = r2 * cs + r1 * sn; r1 = a; r2 = b; }
                    const f32x4 t0 = v[1][0] * rn * gn[1][0], t1 = v[1][1] * rn * gn[1][1];
                    bf16_t* dp = dst + (size_t)row * 1024 + grp * 64 + 8 * fq;
                    *(u32x4*)dp = pack8(r1, r2); *(u32x4*)(dp + 32) = pack8(t0, t1); } }
            return;
        }
        bf16_t* dst; int ldc, colt;
        if (typ < 2) { dst = SG; ldc = 2048; colt = u.pn * BM; } else if (typ == 2) { dst = UV; ldc = 1024; colt = (u.pn - 8) * BM; } else { dst = VB; ldc = 1024; colt = (u.pn - 20) * BM; }
        const int col0 = colt + wc * 32 + 8 * fq;
#pragma unroll
        for (int ai = 0; ai < 2; ++ai)
#pragma unroll
            for (int m = 0; m < 4; ++m) { const int row = row0 + ai * HALF + m * 16; const float rs = rsv[ai][m];
#pragma unroll
                for (int bj = 0; bj < 2; ++bj) { f32x4 v0, v1;
                    if (typ < 2) { const float c1 = -1.4426950408889634f * rs; const f32x4 t0 = acc[ai][bj][m][0] * c1, t1 = acc[ai][bj][m][1] * c1;
#pragma unroll
                        for (int i = 0; i < 4; ++i) { v0[i] = __builtin_amdgcn_rcpf(1.0f + __builtin_amdgcn_exp2f(t0[i])); v1[i] = __builtin_amdgcn_rcpf(1.0f + __builtin_amdgcn_exp2f(t1[i])); } }
                    else { v0 = acc[ai][bj][m][0] * rs; v1 = acc[ai][bj][m][1] * rs; if (typ == 2) { v0 = gelu4(v0); v1 = gelu4(v1); } }
                    if (typ < 2) __builtin_nontemporal_store(pack8(v0, v1), (u32x4*)(dst + (size_t)row * ldc + col0 + bj * HALF)); else *(u32x4*)(dst + (size_t)row * ldc + col0 + bj * HALF) = pack8(v0, v1); } }
    }
};
struct EpiPlainH {
    static constexpr bool PERM = true, AFTER_DRAIN = false;
    bf16_t* H; int ldh;
    __device__ __forceinline__ void operator()(const f32x4 (&acc)[2][2][4][2], const Unit& u, int wr, int wc, int fr, int fq) const {
        const int row0 = u.pm * BM + wr * 64 + fr, col0 = u.pn * HALF + wc * 32 + 8 * fq;
#pragma unroll
        for (int ai = 0; ai < 2; ++ai)
#pragma unroll
            for (int m = 0; m < 4; ++m) { const int row = row0 + ai * HALF + m * 16;
                *(u32x4*)(H + (size_t)row * ldh + col0) = pack8(acc[ai][0][m][0] + acc[ai][1][m][0], acc[ai][0][m][1] + acc[ai][1][m][1]); }
    }
};
template <class Epi, class Sched, bool ALIGN_EPI = false, bool SP2 = false>
__device__ __forceinline__ void gemm_phase(PG8_LAS unsigned char* lds, const Gemm g, const Sched& S, const Epi& E) {
    int tid_ = threadIdx.x; asm volatile("" : "+v"(tid_));
    const int tid = tid_, wid = __builtin_amdgcn_readfirstlane(tid >> 6), lane = tid & 63, wr = wid >> 2, wc = wid & 3, fr = lane & 15, fq = lane >> 4;
    int K_ = g.K; asm volatile("" : "+s"(K_));
    const int K = K_, nt = K / BK;
    unsigned voffA[2], voffB[2];
#pragma unroll
    for (int i = 0; i < 2; ++i) { int R, C; stage_rc(tid * 16 + i * 8192, R, C); const int Rb = Epi::PERM ? ((R & ~31) + perm32(R & 31)) : R;
        voffA[i] = (unsigned)(R * K + C) * 2u; voffB[i] = (unsigned)(Rb * K + C) * 2u; }
    const size_t kstep = (size_t)(BK * 2);
    const size_t hstep = (size_t)HALF * K * 2;
    const size_t tstep = 2 * hstep;
    const unsigned ldsw = (unsigned)wid * 1024u;
    const int aoff = lds_byte(wr * 64 + fr, fq * 8), boff = lds_byte(wc * 32 + fr, fq * 8);
#define PG8_SA(b, h) (((b) * 2 + (h)) * HTB)
#define PG8_SB(b, h) ((4 + (b) * 2 + (h)) * HTB)
#define PG8_STAGE(bufoff, gbase, voff) do { _Pragma("unroll") for (int _i = 0; _i < 2; ++_i) \
        __builtin_amdgcn_global_load_lds((const unsigned*)((const char*)(gbase) + (voff)[_i]), (PG8_LAS unsigned*)(lds + (bufoff) + ldsw + _i * 8192), 16, 0, 0); } while (0)
#define PG8_LDA(dst, b, h) do { _Pragma("unroll") for (int m = 0; m < 4; ++m) _Pragma("unroll") for (int k = 0; k < 2; ++k) dst[m][k] = *(const PG8_LAS bf16x8*)(lds + PG8_SA(b, h) + aoff + m * 2048 + k * 1024); } while (0)
#define PG8_LDB(dst, b, h) do { _Pragma("unroll") for (int n = 0; n < 2; ++n) _Pragma("unroll") for (int k = 0; k < 2; ++k) dst[n][k] = *(const PG8_LAS bf16x8*)(lds + PG8_SB(b, h) + boff + n * 2048 + k * 1024); } while (0)
#define PG8_MMA(ai, bj, At, Bt) do { __builtin_amdgcn_s_setprio(1); _Pragma("unroll") for (int m = 0; m < 4; ++m) _Pragma("unroll") for (int n = 0; n < 2; ++n) _Pragma("unroll") for (int k = 0; k < 2; ++k) \
        acc[ai][bj][m][n] = __builtin_amdgcn_mfma_f32_16x16x32_bf16(Bt[n][k], At[m][k], acc[ai][bj][m][n], 0, 0, 0); __builtin_amdgcn_s_setprio(0); } while (0)
#define PG8_WAIT_V(n) asm volatile("s_waitcnt vmcnt(" #n ")" ::: "memory")
#define PG8_WAIT_L(n) asm volatile("s_waitcnt lgkmcnt(" #n ")" ::: "memory")
#define PG8_BAR __builtin_amdgcn_s_barrier()
#define PG8_SCHED __builtin_amdgcn_sched_barrier(0)
    Unit cur, nxt; int ui = 0;
    if (!S.next(0, cur)) return;
    f32x4 acc[2][2][4][2];
#pragma unroll
    for (int a = 0; a < 2; ++a)
#pragma unroll
        for (int b = 0; b < 2; ++b)
#pragma unroll
            for (int m = 0; m < 4; ++m)
#pragma unroll
                for (int n = 0; n < 2; ++n) acc[a][b][m][n] = (f32x4){0.f, 0.f, 0.f, 0.f};
    bf16x8 At[4][2], B0[2][2], B1[2][2];
    const char* cA = (const char*)g.A + (size_t)cur.pm * tstep; const char* cB = (const char*)g.Bt + (size_t)cur.pn * tstep;
    S.a_ready(cur);
    if constexpr (SP2) {
        PG8_STAGE(PG8_SB(0, 0), cB, voffB); PG8_STAGE(PG8_SB(0, 1), cB + hstep, voffB); PG8_STAGE(PG8_SA(0, 0), cA, voffA); PG8_STAGE(PG8_SA(0, 1), cA + hstep, voffA);
        if (wr == 1) PG8_BAR;
        PG8_WAIT_V(2); PG8_BAR;
        PG8_STAGE(PG8_SB(1, 0), cB + kstep, voffB); PG8_STAGE(PG8_SA(1, 0), cA + kstep, voffA); PG8_STAGE(PG8_SB(1, 1), cB + hstep + kstep, voffB);
        PG8_WAIT_V(6); PG8_BAR;
    } else {
        PG8_STAGE(PG8_SB(0, 0), cB, voffB); PG8_STAGE(PG8_SA(0, 0), cA, voffA); PG8_STAGE(PG8_SB(0, 1), cB + hstep, voffB); PG8_STAGE(PG8_SA(0, 1), cA + hstep, voffA);
        if (wr == 1) PG8_BAR;
        PG8_WAIT_V(4); PG8_BAR;
        PG8_STAGE(PG8_SB(1, 0), cB + kstep, voffB); PG8_STAGE(PG8_SA(1, 0), cA + kstep, voffA); PG8_STAGE(PG8_SB(1, 1), cB + hstep + kstep, voffB);
        PG8_WAIT_V(6); PG8_BAR;
    }
    for (;;) {
        const bool has_next = S.next(ui + 1, nxt);
        const char* nA = has_next ? (const char*)g.A + (size_t)nxt.pm * tstep : cA; const char* nB = has_next ? (const char*)g.Bt + (size_t)nxt.pn * tstep : cB;
        for (int t = 0; t < nt; t += 2) {
            const bool last = (t == nt - 2);
            const char* a1 = cA + (size_t)(t + 1) * kstep;
            const char* a2 = last ? nA : cA + (size_t)(t + 2) * kstep; const char* b2 = last ? nB : cB + (size_t)(t + 2) * kstep;
            const char* a3 = a2 + kstep; const char* b3 = b2 + kstep;
            if (last && has_next) S.a_ready(nxt);
            if constexpr (SP2) {
            PG8_LDB(B0, 0, 0); PG8_LDB(B1, 0, 1); PG8_SCHED; PG8_LDA(At, 0, 0); PG8_STAGE(PG8_SA(1, 1), a1 + hstep, voffA);
            PG8_WAIT_V(8); PG8_WAIT_L(0); PG8_BAR; PG8_MMA(0, 0, At, B0); PG8_MMA(0, 1, At, B1); PG8_BAR; PG8_SCHED;
            PG8_LDA(At, 0, 1); PG8_STAGE(PG8_SB(0, 0), b2, voffB); PG8_STAGE(PG8_SB(0, 1), b2 + hstep, voffB); PG8_STAGE(PG8_SA(0, 0), a2, voffA);
            PG8_WAIT_V(8); PG8_WAIT_L(0); PG8_BAR; PG8_MMA(1, 0, At, B0); PG8_MMA(1, 1, At, B1); PG8_BAR; PG8_SCHED;
            PG8_LDB(B0, 1, 0); PG8_LDB(B1, 1, 1); PG8_SCHED; PG8_LDA(At, 1, 0); PG8_STAGE(PG8_SA(0, 1), a2 + hstep, voffA);
            PG8_WAIT_V(8); PG8_WAIT_L(0); PG8_BAR; PG8_MMA(0, 0, At, B0); PG8_MMA(0, 1, At, B1); PG8_BAR; PG8_SCHED;
            PG8_LDA(At, 1, 1); PG8_STAGE(PG8_SB(1, 0), b3, voffB); PG8_STAGE(PG8_SB(1, 1), b3 + hstep, voffB); PG8_STAGE(PG8_SA(1, 0), a3, voffA);
            PG8_WAIT_V(8); PG8_WAIT_L(0); PG8_BAR; PG8_MMA(1, 0, At, B0); PG8_MMA(1, 1, At, B1); PG8_BAR; PG8_SCHED;
            } else {
            PG8_LDB(B0, 0, 0); PG8_SCHED; PG8_LDA(At, 0, 0); PG8_STAGE(PG8_SA(1, 1), a1 + hstep, voffA);
            PG8_WAIT_L(8); PG8_BAR; PG8_WAIT_L(0); PG8_MMA(0, 0, At, B0); PG8_BAR; PG8_SCHED;
            PG8_LDB(B1, 0, 1); PG8_STAGE(PG8_SB(0, 0), b2, voffB);
            PG8_BAR; PG8_WAIT_L(0); PG8_MMA(0, 1, At, B1); PG8_BAR;
            PG8_LDA(At, 0, 1); PG8_STAGE(PG8_SA(0, 0), a2, voffA);
            PG8_BAR; PG8_WAIT_L(0); PG8_MMA(1, 0, At, B0); PG8_BAR; PG8_SCHED;
            PG8_STAGE(PG8_SB(0, 1), b2 + hstep, voffB);
            PG8_WAIT_V(6); PG8_BAR; PG8_MMA(1, 1, At, B1); PG8_BAR;
            PG8_LDB(B0, 1, 0); PG8_SCHED; PG8_LDA(At, 1, 0); PG8_STAGE(PG8_SA(0, 1), a2 + hstep, voffA);
            PG8_WAIT_L(8); PG8_BAR; PG8_WAIT_L(0); PG8_MMA(0, 0, At, B0); PG8_BAR; PG8_SCHED;
            PG8_LDB(B1, 1, 1); PG8_STAGE(PG8_SB(1, 0), b3, voffB);
            PG8_BAR; PG8_WAIT_L(0); PG8_MMA(0, 1, At, B1); PG8_BAR;
            PG8_LDA(At, 1, 1); PG8_STAGE(PG8_SA(1, 0), a3, voffA);
            PG8_BAR; PG8_WAIT_L(0); PG8_MMA(1, 0, At, B0); PG8_BAR; PG8_SCHED;
            PG8_STAGE(PG8_SB(1, 1), b3 + hstep, voffB);
            PG8_WAIT_V(6); PG8_BAR; PG8_MMA(1, 1, At, B1); PG8_BAR;
            }
        }
        if constexpr (ALIGN_EPI) { if (wr == 0) PG8_BAR; }
        if constexpr (!Epi::AFTER_DRAIN) { E(acc, cur, wr, wc, fr, fq); S.done(cur); }
        if (!has_next) break;
#pragma unroll
        for (int a = 0; a < 2; ++a)
#pragma unroll
            for (int b = 0; b < 2; ++b)
#pragma unroll
                for (int m = 0; m < 4; ++m)
#pragma unroll
                    for (int n = 0; n < 2; ++n) acc[a][b][m][n] = (f32x4){0.f, 0.f, 0.f, 0.f};
        cur = nxt; cA = nA; cB = nB; ++ui;
        if constexpr (ALIGN_EPI) { if (wr == 1) PG8_BAR; }
    }
    PG8_WAIT_V(0);
    if constexpr (!ALIGN_EPI) { if (wr == 0) PG8_BAR; }
    PG8_BAR;
    if constexpr (Epi::AFTER_DRAIN) { E.fused(acc, cur, wr, wc, fr, fq, lds, wid, lane); S.done(cur); }
#undef PG8_SA
#undef PG8_SB
#undef PG8_STAGE
#undef PG8_LDA
#undef PG8_LDB
#undef PG8_MMA
#undef PG8_WAIT_V
#undef PG8_WAIT_L
#undef PG8_BAR
#undef PG8_SCHED
}
}

constexpr int BATCH = 8, SEQ = 4096, DM = 1024, DFF = 2816, AW = 512, NH = 8, INC = 6144;
constexpr int MT = BATCH * SEQ;
constexpr int NWAVES = 8;
constexpr float QSCALE = 0.125f * 1.4426950408889634f;
constexpr float LAM_INIT = 0.2f;

constexpr size_t MiB = 1u << 20;
constexpr size_t WS_W1GU = 0;
constexpr size_t WS_W1D  = WS_W1GU + (size_t)2 * DFF * DM * 2;
constexpr size_t WS_WIN  = WS_W1D + (size_t)DM * DFF * 2;
constexpr size_t WS_WPA  = WS_WIN + (size_t)INC * DM * 2;
constexpr size_t WS_WPB  = WS_WPA + (size_t)DM * AW * 2;
constexpr size_t WS_WO   = WS_WPB + (size_t)DM * DM * 2;
constexpr size_t WS_W2GU = WS_WO + (size_t)DM * DM * 2;
constexpr size_t WS_W2D  = WS_W2GU + (size_t)2 * DFF * DM * 2;
constexpr size_t WS_WSP  = WS_W2D + (size_t)DM * DFF * 2;
constexpr size_t WS_ROPE = WS_WSP + (size_t)8 * 128 * 128 * 2;
constexpr size_t WS_SS   = WS_ROPE + (size_t)MT * 16 * 4;
constexpr size_t WS_R0END = WS_SS + (size_t)MT * 16 * 4;
static_assert(WS_R0END <= 64 * MiB, "weights region");
constexpr size_t WS_CTL = 60 * MiB, CTL_ZERO_BYTES = 65536;
static_assert(WS_R0END <= WS_CTL, "ctl");
constexpr size_t WS_XB = 64 * MiB;
constexpr size_t WS_YA = WS_XB;
constexpr size_t WS_H  = 128 * MiB;
constexpr size_t WS_SG = 128 * MiB;
constexpr size_t WS_UV = 256 * MiB;
constexpr size_t WS_MM = WS_UV;
constexpr size_t WS_Q  = 320 * MiB;
constexpr size_t WS_YB = WS_Q;
constexpr size_t WS_K  = 384 * MiB;
constexpr size_t WS_V  = 448 * MiB;
constexpr size_t WS_END = 512 * MiB;
static_assert(WS_H + (size_t)MT * DFF * 2 <= WS_Q, "H overlay");

constexpr int LDS_BYTES = 147456;

#define LAS __attribute__((address_space(3)))
typedef unsigned short bf16;
typedef float f32x4 __attribute__((ext_vector_type(4)));
typedef float f32x16 __attribute__((ext_vector_type(16)));
typedef short bf16x8 __attribute__((ext_vector_type(8)));
typedef short s16x4 __attribute__((ext_vector_type(4)));
typedef unsigned u32x4 __attribute__((ext_vector_type(4)));
typedef unsigned u32x2 __attribute__((ext_vector_type(2)));
#define LDS_WAIT() asm volatile("s_waitcnt lgkmcnt(0)" ::: "memory")
#define MFMA32(a, b, c) __builtin_amdgcn_mfma_f32_32x32x16_bf16((a), (b), (c), 0, 0, 0)
__device__ __forceinline__ unsigned f2bf(float f) { unsigned u = __builtin_bit_cast(unsigned, f); return (u + 0x7fffu + ((u >> 16) & 1u)) >> 16; }
__device__ __forceinline__ unsigned pk2(float lo, float hi) { typedef float f2_t __attribute__((ext_vector_type(2))); typedef __bf16 b2_t __attribute__((ext_vector_type(2))); const f2_t v = {lo, hi}; return __builtin_bit_cast(unsigned, __builtin_convertvector(v, b2_t)); }
__device__ __forceinline__ float bflo(unsigned w) { return __uint_as_float(w << 16); }
__device__ __forceinline__ float bfhi(unsigned w) { return __uint_as_float(w & 0xffff0000u); }
__device__ __forceinline__ float wave_sum(float v) {
#pragma unroll
    for (int o = 1; o < 64; o <<= 1) v += __shfl_xor(v, o);
    return v;
}
__device__ __forceinline__ int crow(int r, int hi) { return (r & 3) + 8 * (r >> 2) + 4 * hi; }
typedef short v4i16_t __attribute__((ext_vector_type(4)));
__device__ __forceinline__ s16x4 vtr(const LAS unsigned char* p) { return __builtin_bit_cast(s16x4, __builtin_amdgcn_ds_read_tr16_b64_v4i16((LAS v4i16_t*)p)); }

#define RLX_AGENT __ATOMIC_RELAXED, __HIP_MEMORY_SCOPE_AGENT
#define XB_TMO      128
#define XB_XCNT(j)  (256  + 64 * (j))
#define XB_XSUB(j)  (1280 + 64 * (j))
#define XB_XGEN(j)  (2304 + 64 * (j))
#define XB_TOP      3328
#define XB_TOPGEN   3392
#define XCD_BAR_WORDS 3456
#define XB_SPIN_CAP (1u << 18)

__device__ __forceinline__ unsigned xb_ld(unsigned* p)              { return __hip_atomic_load(p, __ATOMIC_RELAXED, __HIP_MEMORY_SCOPE_AGENT); }
__device__ __forceinline__ unsigned xb_add(unsigned* p, unsigned v) { return __hip_atomic_fetch_add(p, v, __ATOMIC_RELAXED, __HIP_MEMORY_SCOPE_AGENT); }
__device__ __forceinline__ unsigned xb_xcc_id() { return (unsigned)__builtin_amdgcn_s_getreg((3 << 11) | 20) & 0xFu; }
#define XB_SPIN(cond, bar) do { unsigned _sp = 0; while (cond) { __builtin_amdgcn_s_sleep(1); \
    if ((++_sp & 255u) == 0u) { if (xb_ld(&(bar)[XB_TMO])) break; if (_sp > XB_SPIN_CAP) { atomicAdd(&(bar)[XB_TMO], 1u); break; } } } } while (0)

struct XcdBarrier {
    unsigned* bar; unsigned x;
    volatile LAS unsigned* st;
};

__device__ __forceinline__ XcdBarrier xcd_barrier_post(unsigned* bar, volatile LAS unsigned* st) {
    XcdBarrier b; b.bar = bar; b.x = xb_xcc_id(); b.st = st;
    if (threadIdx.x == 0) (void)xb_add(&bar[XB_XCNT(b.x)], 1u);
    return b;
}
__device__ __forceinline__ void xcd_barrier_complete(unsigned* bar, unsigned x, unsigned& nloc, unsigned& nx) {
    const unsigned G = gridDim.x * gridDim.y * gridDim.z;
    unsigned sum, cnt, mine, sp = 0u;
    for (;;) {
        sum = 0u; cnt = 0u; mine = 0u;
#pragma unroll
        for (unsigned j = 0; j < 16; ++j) { const unsigned c = xb_ld(&bar[XB_XCNT(j)]); sum += c; cnt += (c > 0u) ? 1u : 0u; mine = (j == x) ? c : mine; }
        if (sum == G) break;
        __builtin_amdgcn_s_sleep(1);
        if ((++sp & 255u) == 0u) { if (xb_ld(&bar[XB_TMO])) break; if (sp > XB_SPIN_CAP) { atomicAdd(&bar[XB_TMO], 1u); break; } }
    }
    nloc = mine > 0u ? mine : 1u; nx = cnt > 0u ? cnt : 1u;
}

__device__ __forceinline__ void xcd_barrier(const XcdBarrier& b) {
    asm volatile("s_waitcnt vmcnt(0)" ::: "memory");
    __syncthreads();
    if (threadIdx.x == 0) {
        unsigned* bar = b.bar;
        __builtin_amdgcn_s_waitcnt(0);
        unsigned nloc = b.st[0], nx = b.st[1];
        if (nloc == 0u) { xcd_barrier_complete(bar, b.x, nloc, nx); b.st[0] = nloc; b.st[1] = nx; }
        const unsigned old = xb_add(&bar[XB_XSUB(b.x)], 1u);
        const unsigned gen = old / nloc;
        if (old + 1u == (gen + 1u) * nloc) {
            __builtin_amdgcn_fence(__ATOMIC_RELEASE, "agent");
            asm volatile("s_waitcnt vmcnt(0)" ::: "memory");
            const unsigned og = xb_add(&bar[XB_TOP], 1u);
            const unsigned tg = og / nx;
            if (og + 1u == (tg + 1u) * nx) xb_add(&bar[XB_TOPGEN], 1u);
            else XB_SPIN(xb_ld(&bar[XB_TOPGEN]) == tg, bar);
            __builtin_amdgcn_fence(__ATOMIC_ACQUIRE, "agent");
            xb_add(&bar[XB_XGEN(b.x)], 1u);
            asm volatile("s_waitcnt vmcnt(0)" ::: "memory");
        } else {
            XB_SPIN(xb_ld(&bar[XB_XGEN(b.x)]) == gen, bar);
            __builtin_amdgcn_fence(__ATOMIC_ACQUIRE, "agent");
            asm volatile("s_waitcnt vmcnt(0)" ::: "memory");
        }
    }
    __syncthreads();
}

#ifndef ATT_VAR
#define ATT_VAR 0
#endif
#ifndef REP_MASK
#define REP_MASK 0
#endif
#define NREP(k) (1 + ((REP_MASK >> (k)) & 1))
struct Args { const float* in[26]; float* out; unsigned char* ws; };

__device__ __forceinline__ int dperm(int p) { return p < 16 ? 4 * (p >> 3) + 8 * ((p >> 2) & 1) + (p & 3) : p; }
__device__ __forceinline__ void conv_item(const float* W, int ldn, int K, int c0, bf16* WT, int drow0, bool perm, const float* gain, LAS float* scr, int kb, int lane) {
    const int k0 = 64 * kb;
    float wv[32];
#pragma unroll
    for (int i = 0; i < 32; ++i) wv[i] = __builtin_nontemporal_load(W + (size_t)(k0 + 2 * i + (lane >> 5)) * ldn + c0 + (lane & 31));
    if (gain) {
#pragma unroll
        for (int i = 0; i < 32; ++i) wv[i] *= gain[k0 + 2 * i + (lane >> 5)];
    }
#pragma unroll
    for (int i = 0; i < 32; ++i) scr[(2 * i + (lane >> 5)) * 33 + (lane & 31)] = wv[i];
    LDS_WAIT(); asm volatile("" ::: "memory");
    const int c = lane & 7;
#pragma unroll
    for (int j = 0; j < 4; ++j) { const int n = (lane >> 3) + 8 * j; const int sc = perm ? dperm(n) : n; const LAS float* s = scr + (8 * c) * 33 + sc;
        u32x4 o; o.x = pk2(s[0 * 33], s[1 * 33]); o.y = pk2(s[2 * 33], s[3 * 33]); o.z = pk2(s[4 * 33], s[5 * 33]); o.w = pk2(s[6 * 33], s[7 * 33]);
        *(u32x4*)(WT + (size_t)(drow0 + n) * K + k0 + 8 * c) = o; }
    LDS_WAIT(); asm volatile("" ::: "memory");
}
__device__ __forceinline__ void conv_gu(const float* wg, const float* wu, const float* gain, bf16* WT, LAS float* scr, int r, int lane) {
    const int db = r >> 4, kb = r & 15; const int pn = db >> 3, bj = (db >> 2) & 1, wcb = db & 3;
    conv_item(bj ? wu : wg, DFF, DM, 128 * pn + 32 * wcb, WT, 32 * db, false, gain, scr, kb, lane);
}
__device__ __forceinline__ void conv_win(const float* w, const float* gain, bf16* WT, LAS float* scr, int r, int lane) {
    const int db = r >> 4, kb = r & 15; const int pn = db >> 3, typ = pn >> 2;
    int c0 = 32 * db; bool perm = false;
    if (typ == 3 || typ == 4) { const int bj = (db >> 2) & 1, wcb = db & 3; const int grp = 4 * (pn & 3) + wcb; c0 = (typ == 3 ? 3072 : 4096) + grp * 64 + 32 * bj; perm = (bj == 0); }
    conv_item(w, INC, DM, c0, WT, 32 * db, perm, gain, scr, kb, lane);
}

__device__ __forceinline__ void gmlp_unit(int chunk, const bf16* UV, const bf16* WSP, const float* lng, const float* lnb, const float* bs, bf16* YA, LAS unsigned char* lds) {
    const int tid = threadIdx.x, lane = tid & 63, wid = __builtin_amdgcn_readfirstlane(tid >> 6);
    const size_t tok0 = (size_t)chunk * 128;
    bf16x8 wfall[4][8];
    {
        f32x4 g0 = *(const f32x4*)(lng + 8 * lane), g1 = *(const f32x4*)(lng + 8 * lane + 4), b0 = *(const f32x4*)(lnb + 8 * lane), b1 = *(const f32x4*)(lnb + 8 * lane + 4);
        u32x4 wv[16];
#pragma unroll
        for (int i = 0; i < 16; ++i) wv[i] = *(const u32x4*)(UV + (tok0 + 16 * wid + i) * 1024 + 512 + 8 * lane);
#pragma unroll
        for (int tb = 0; tb < 4; ++tb)
#pragma unroll
            for (int ks = 0; ks < 8; ++ks) if (ks < 2 * (tb + 1)) wfall[tb][ks] = *(const bf16x8*)(WSP + (size_t)wid * 128 * 128 + (size_t)(32 * tb + (lane & 31)) * 128 + 16 * ks + 8 * (lane >> 5));
#pragma unroll
        for (int i0 = 0; i0 < 16; i0 += 4) {
            f32x4 x0[4], x1[4]; float sm[4], sq[4];
#pragma unroll
            for (int q = 0; q < 4; ++q) { const u32x4 w = wv[i0 + q];
                x0[q] = (f32x4){bflo(w.x), bfhi(w.x), bflo(w.y), bfhi(w.y)}; x1[q] = (f32x4){bflo(w.z), bfhi(w.z), bflo(w.w), bfhi(w.w)};
                sm[q] = (x0[q][0] + x0[q][1]) + (x0[q][2] + x0[q][3]) + (x1[q][0] + x1[q][1]) + (x1[q][2] + x1[q][3]);
                sq[q] = (x0[q][0] * x0[q][0] + x0[q][1] * x0[q][1]) + (x0[q][2] * x0[q][2] + x0[q][3] * x0[q][3]) + (x1[q][0] * x1[q][0] + x1[q][1] * x1[q][1]) + (x1[q][2] * x1[q][2] + x1[q][3] * x1[q][3]); }
#pragma unroll
            for (int o = 1; o < 64; o <<= 1)
#pragma unroll
                for (int q = 0; q < 4; ++q) { sm[q] += __shfl_xor(sm[q], o); sq[q] += __shfl_xor(sq[q], o); }
#pragma unroll
            for (int q = 0; q < 4; ++q) { const int row = 16 * wid + i0 + q;
                const float mean = sm[q] * (1.0f / 512.0f); const float var = fmaxf(sq[q] * (1.0f / 512.0f) - mean * mean, 0.f);
                const float rstd = 1.0f / sqrtf(var + 1e-5f);
                const f32x4 y0 = (x0[q] - mean) * rstd * g0 + b0, y1 = (x1[q] - mean) * rstd * g1 + b1;
                u32x4 o; o.x = pk2(y0[0], y0[1]); o.y = pk2(y0[2], y0[3]); o.z = pk2(y1[0], y1[1]); o.w = pk2(y1[2], y1[3]);
                *(LAS u32x4*)(lds + row * 1024 + ((lane ^ ((row & 3) << 2)) << 4)) = o; }
        }
    }
    __syncthreads();
    {
        const int g = wid, r32 = lane & 31, h8 = lane >> 5;
        const bf16* Wg = WSP + (size_t)g * 128 * 128;
#pragma unroll
        for (int tb = 0; tb < 4; ++tb) {
            f32x16 acc[2];
#pragma unroll
            for (int eb = 0; eb < 2; ++eb)
#pragma unroll
                for (int r = 0; r < 16; ++r) acc[eb][r] = 0.f;
            const int t = 32 * tb + r32; const bf16* up = UV + (tok0 + t) * 1024 + 64 * g; bf16* yp = YA + (tok0 + t) * 512 + 64 * g;
            u32x4 uq[4];
#pragma unroll
            for (int q = 0; q < 4; ++q) uq[q] = *(const u32x4*)(up + 16 * q + 8 * h8);
            const int nks = 2 * (tb + 1);
#pragma unroll
            for (int ks = 0; ks < 8; ++ks) { if (ks >= nks) break;
                const bf16x8 wf = wfall[tb][ks];
#pragma unroll
                for (int eb = 0; eb < 2; ++eb) {
                    const int q = (lane >> 2) & 3; const int ch = 8 * g + 4 * eb + 2 * ((lane >> 4) & 1) + ((lane & 3) >> 1);
                    const int srow = 16 * ks + 8 * h8 + q;
                    const LAS unsigned char* p0 = lds + srow * 1024 + ((ch ^ (q << 2)) << 4) + 8 * (lane & 1);
                    const s16x4 lo = vtr(p0), hi = vtr(p0 + 4 * 1024);
                    const bf16x8 vf = __builtin_shufflevector(lo, hi, 0, 1, 2, 3, 4, 5, 6, 7);
                    acc[eb] = MFMA32(vf, wf, acc[eb]);
                }
            }
            const float bias = bs[g * 128 + t];
#pragma unroll
            for (int eb = 0; eb < 2; ++eb)
#pragma unroll
                for (int k = 0; k < 2; ++k) {
                    const u32x4 uw4 = uq[2 * eb + k];
                    const auto s0 = __builtin_amdgcn_permlane32_swap(uw4.x, uw4.z, false, false), s1 = __builtin_amdgcn_permlane32_swap(uw4.y, uw4.w, false, false);
                    const unsigned ua_x = s0[0], ua_y = s1[0], ub_x = s0[1], ub_y = s1[1];
                    u32x2 oa, ob;
                    { const int g4 = 2 * k; const float f0 = acc[eb][4 * g4 + 0] + bias, f1 = acc[eb][4 * g4 + 1] + bias, f2 = acc[eb][4 * g4 + 2] + bias, f3 = acc[eb][4 * g4 + 3] + bias;
                      oa.x = pk2(bflo(ua_x) * f0, bfhi(ua_x) * f1); oa.y = pk2(bflo(ua_y) * f2, bfhi(ua_y) * f3); }
                    { const int g4 = 2 * k + 1; const float f0 = acc[eb][4 * g4 + 0] + bias, f1 = acc[eb][4 * g4 + 1] + bias, f2 = acc[eb][4 * g4 + 2] + bias, f3 = acc[eb][4 * g4 + 3] + bias;
                      ob.x = pk2(bflo(ub_x) * f0, bfhi(ub_x) * f1); ob.y = pk2(bflo(ub_y) * f2, bfhi(ub_y) * f3); }
                    const auto r0 = __builtin_amdgcn_permlane32_swap(oa.x, ob.x, false, false), r1 = __builtin_amdgcn_permlane32_swap(oa.y, ob.y, false, false);
                    u32x4 w; w.x = r0[0]; w.y = r1[0]; w.z = r0[1]; w.w = r1[1];
                    *(u32x4*)(yp + 32 * eb + 16 * k + 8 * h8) = w; }
        }
    }
    __syncthreads();
}

template <bool STORE, int VAR = 0> __device__ __forceinline__ void attn_unit(int b, int h, int qb, const bf16* Q, const bf16* K, const bf16* V, bf16* YB, LAS unsigned char* lds, float lam, const float* subln) {
    int tid_ = threadIdx.x; asm volatile("" : "+v"(tid_));
    const int tid = tid_, lane = tid & 63, wid = __builtin_amdgcn_readfirstlane(tid >> 6);
    const int m = wid >> 2, wq = wid & 3, r32 = lane & 31, h8 = lane >> 5;
    const size_t tok0 = (size_t)b * SEQ; const int q0 = qb * 128; const int qrow = q0 + 32 * wq + r32;
    constexpr int STG = 32768; constexpr float THR = 8.0f;
    bf16x8 qf[4];
    { const bf16* qp = Q + (tok0 + qrow) * 1024 + (2 * h + m) * 64 + 8 * h8;
#pragma unroll
      for (int s = 0; s < 4; ++s) qf[s] = *(const bf16x8*)(qp + 16 * s); }
    const int srow0 = tid >> 4, sch = tid & 15;
    const bf16* kg = K + (tok0 + srow0) * 1024 + h * 128 + sch * 8; const bf16* vg = V + (tok0 + srow0) * 1024 + h * 128 + sch * 8;
    unsigned kdst[2], vdst[2];
#pragma unroll
    for (int i = 0; i < 2; ++i) { const int row = srow0 + 32 * i; kdst[i] = (sch >> 3) * 8192 + row * 128 + (((sch & 7) ^ ((row >> 1) & 7)) << 4); vdst[i] = 16384 + row * 256 + ((sch ^ ((row & 3) << 2)) << 4); }
    const int nt = 2 * (qb + 1);
    u32x4 kr[2], vr[2];
#pragma unroll
    for (int t = 0; t < 2; ++t) {
#pragma unroll
        for (int i = 0; i < 2; ++i) { kr[i] = *(const u32x4*)(kg + (size_t)(64 * t + 32 * i) * 1024); vr[i] = *(const u32x4*)(vg + (size_t)(64 * t + 32 * i) * 1024); }
#pragma unroll
        for (int i = 0; i < 2; ++i) { *(LAS u32x4*)(lds + t * STG + kdst[i]) = kr[i]; *(LAS u32x4*)(lds + t * STG + vdst[i]) = vr[i]; }
    }
    __syncthreads();
    f32x16 oT[4], sT[2]; bf16x8 pf[4];
#pragma unroll
    for (int d = 0; d < 4; ++d)
#pragma unroll
        for (int r = 0; r < 16; ++r) oT[d][r] = 0.f;
#pragma unroll
    for (int s = 0; s < 4; ++s) pf[s] = (bf16x8){0, 0, 0, 0, 0, 0, 0, 0};
    float mrun = 0.f, lsum = 0.f;
    f32x16 negm;
#pragma unroll
    for (int r = 0; r < 16; ++r) negm[r] = 0.f;
    const int kq = (lane >> 2) & 3;
    const int ksw = (r32 >> 1) & 7;
    const unsigned koff = m * 8192 + r32 * 128, kc0 = ((0 + h8) ^ ksw) << 4, kc1 = ((2 + h8) ^ ksw) << 4, kc2 = ((4 + h8) ^ ksw) << 4, kc3 = ((6 + h8) ^ ksw) << 4;
    const unsigned voff = 16384 + (4 * h8 + kq) * 256 + 8 * (lane & 1); const int vch = 2 * ((lane >> 4) & 1) + ((lane & 3) >> 1);
#define SB() __builtin_amdgcn_sched_barrier(0)
#define ATT_KLD(dst, st, kb) do { const LAS unsigned char* kp_ = lds + (st) + koff + (kb) * 4096; \
        dst[0] = *(const LAS bf16x8*)(kp_ + kc0); dst[1] = *(const LAS bf16x8*)(kp_ + kc1); dst[2] = *(const LAS bf16x8*)(kp_ + kc2); dst[3] = *(const LAS bf16x8*)(kp_ + kc3); } while (0)
#define ATT_VLD(lo, hi, st, d) do { const LAS unsigned char* vp_ = lds + (st) + voff + ((((4 * (d)) + vch) ^ (kq << 2)) << 4); \
        _Pragma("unroll") for (int s = 0; s < 4; ++s) { lo[s] = vtr(vp_ + (16 * s) * 256); hi[s] = vtr(vp_ + (16 * s + 8) * 256); } } while (0)
#define ATT_VF(lo, hi, s) __builtin_shufflevector(lo[s], hi[s], 0, 1, 2, 3, 4, 5, 6, 7)
#define ATT_MMA(stv, sts, DO_S) do { \
        bf16x8 kfa_[4], kfb_[4]; s16x4 vla_[4], vha_[4], vlb_[4], vhb_[4]; \
        __builtin_amdgcn_s_setprio(1); \
        if (DO_S) { ATT_KLD(kfa_, sts, 0); } ATT_VLD(vla_, vha_, stv, 0); SB(); \
        if (DO_S) { ATT_KLD(kfb_, sts, 1); \
            sT[0] = MFMA32(kfa_[0], qf[0], negm); \
            _Pragma("unroll") for (int s = 1; s < 4; ++s) sT[0] = MFMA32(kfa_[s], qf[s], sT[0]); SB(); \
            sT[1] = MFMA32(kfb_[0], qf[0], negm); \
            _Pragma("unroll") for (int s = 1; s < 4; ++s) sT[1] = MFMA32(kfb_[s], qf[s], sT[1]); SB(); } \
        ATT_VLD(vlb_, vhb_, stv, 1); \
        _Pragma("unroll") for (int s = 0; s < 4; ++s) oT[0] = MFMA32(ATT_VF(vla_, vha_, s), pf[s], oT[0]); SB(); \
        ATT_VLD(vla_, vha_, stv, 2); \
        _Pragma("unroll") for (int s = 0; s < 4; ++s) oT[1] = MFMA32(ATT_VF(vlb_, vhb_, s), pf[s], oT[1]); SB(); \
        ATT_VLD(vlb_, vhb_, stv, 3); \
        _Pragma("unroll") for (int s = 0; s < 4; ++s) oT[2] = MFMA32(ATT_VF(vla_, vha_, s), pf[s], oT[2]); SB(); \
        _Pragma("unroll") for (int s = 0; s < 4; ++s) oT[3] = MFMA32(ATT_VF(vlb_, vhb_, s), pf[s], oT[3]); __builtin_amdgcn_s_setprio(0); SB(); } while (0)
#define MAX3(a, b, c) ({ float r_; asm("v_max3_f32 %0, %1, %2, %3" : "=v"(r_) : "v"(a), "v"(b), "v"(c)); r_; })
#define ATT_SOFTMAX(j) do { \
        if ((j) >= nt - 2) { \
            _Pragma("unroll") for (int kb = 0; kb < 2; ++kb) \
            _Pragma("unroll") for (int r = 0; r < 16; ++r) { const int kv_ = 64 * (j) + 32 * kb + crow(r, h8); if (kv_ > qrow) sT[kb][r] = -INFINITY; } } \
        float ta_ = MAX3(sT[0][0], sT[0][1], sT[0][2]), tb_ = MAX3(sT[1][0], sT[1][1], sT[1][2]); \
        _Pragma("unroll") for (int r = 3; r < 15; r += 2) { ta_ = MAX3(ta_, sT[0][r], sT[0][r + 1]); tb_ = MAX3(tb_, sT[1][r], sT[1][r + 1]); } \
        float tmax_ = MAX3(ta_, tb_, sT[0][15]); tmax_ = MAX3(tmax_, sT[1][15], sT[1][15]); \
        { auto rr_ = __builtin_amdgcn_permlane32_swap(__float_as_uint(tmax_), __float_as_uint(tmax_), false, false); tmax_ = MAX3(__uint_as_float(rr_[0]), __uint_as_float(rr_[1]), __uint_as_float(rr_[1])); } \
        if ((j) == 0 || __any(tmax_ > THR)) { const float dl_ = ((j) == 0) ? tmax_ : fmaxf(tmax_, 0.f); mrun += dl_; const float al_ = __builtin_amdgcn_exp2f(-dl_); lsum *= al_; \
            _Pragma("unroll") for (int d = 0; d < 4; ++d) _Pragma("unroll") for (int r = 0; r < 16; ++r) oT[d][r] *= al_; \
            _Pragma("unroll") for (int kb = 0; kb < 2; ++kb) _Pragma("unroll") for (int r = 0; r < 16; ++r) sT[kb][r] -= dl_; \
            _Pragma("unroll") for (int r = 0; r < 16; ++r) negm[r] = -mrun; } \
        _Pragma("unroll") for (int kb = 0; kb < 2; ++kb) \
        _Pragma("unroll") for (int r = 0; r < 16; ++r) sT[kb][r] = __builtin_amdgcn_exp2f(sT[kb][r]); \
        float p0_ = sT[0][0] + sT[0][1], p1_ = sT[0][2] + sT[0][3], p2_ = sT[1][0] + sT[1][1], p3_ = sT[1][2] + sT[1][3]; \
        _Pragma("unroll") for (int r = 4; r < 16; r += 4) { p0_ += sT[0][r]; p1_ += sT[0][r + 2]; p2_ += sT[1][r]; p3_ += sT[1][r + 2]; p0_ += sT[0][r + 1]; p1_ += sT[0][r + 3]; p2_ += sT[1][r + 1]; p3_ += sT[1][r + 3]; } \
        lsum += (p0_ + p1_) + (p2_ + p3_); \
        _Pragma("unroll") for (int s = 0; s < 4; ++s) { u32x4 w_; \
            w_.x = pg8::cvt_pk_bf16(sT[s >> 1][8 * (s & 1) + 0], sT[s >> 1][8 * (s & 1) + 1]); w_.y = pg8::cvt_pk_bf16(sT[s >> 1][8 * (s & 1) + 2], sT[s >> 1][8 * (s & 1) + 3]); \
            w_.z = pg8::cvt_pk_bf16(sT[s >> 1][8 * (s & 1) + 4], sT[s >> 1][8 * (s & 1) + 5]); w_.w = pg8::cvt_pk_bf16(sT[s >> 1][8 * (s & 1) + 6], sT[s >> 1][8 * (s & 1) + 7]); \
            pf[s] = __builtin_bit_cast(bf16x8, w_); } } while (0)
    if (m == 1) __builtin_amdgcn_s_barrier();
    int stV = 0, stS = 0, stW = 2 * STG;
    for (int it = 0; it < nt; ++it) {
        const bool ld = (it + 2 < nt);
        if (ld) {
#pragma unroll
            for (int i = 0; i < 2; ++i) { kr[i] = *(const u32x4*)(kg + (size_t)(64 * (it + 2) + 32 * i) * 1024); vr[i] = *(const u32x4*)(vg + (size_t)(64 * (it + 2) + 32 * i) * 1024); }
        }
        if (VAR != 2 && VAR != 3) ATT_MMA(stV, stS, true);
        asm volatile("s_waitcnt lgkmcnt(0)" ::: "memory"); __builtin_amdgcn_s_barrier(); asm volatile("" ::: "memory");
        if (VAR != 1 && VAR != 3) ATT_SOFTMAX(it);
        if (ld) {
#pragma unroll
            for (int i = 0; i < 2; ++i) { *(LAS u32x4*)(lds + stW + kdst[i]) = kr[i]; *(LAS u32x4*)(lds + stW + vdst[i]) = vr[i]; }
        }
        __syncthreads();
        stV = stS; stS = (stS == 3 * STG) ? 0 : stS + STG; stW = (stW == 3 * STG) ? 0 : stW + STG;
    }
    ATT_MMA(stV, stS, false);
    __syncthreads();
    __syncthreads();
    if (m == 0) __builtin_amdgcn_s_barrier();
#undef ATT_MMA
#undef ATT_KLD
#undef ATT_VLD
#undef ATT_VF
#undef SB
#undef ATT_SOFTMAX
#undef MAX3
    { auto rr = __builtin_amdgcn_permlane32_swap(__float_as_uint(lsum), __float_as_uint(lsum), false, false); lsum = __uint_as_float(rr[0]) + __uint_as_float(rr[1]); }
    const float inv = 1.0f / lsum;
    LAS float* cmb = (LAS float*)lds + wq * 4096;
    if (m == 1) {
#pragma unroll
        for (int d = 0; d < 4; ++d)
#pragma unroll
            for (int r4 = 0; r4 < 4; ++r4) *(LAS f32x4*)(cmb + ((d * 4 + r4) * 64 + lane) * 4) = (f32x4){oT[d][4 * r4] * inv, oT[d][4 * r4 + 1] * inv, oT[d][4 * r4 + 2] * inv, oT[d][4 * r4 + 3] * inv};
    }
    __syncthreads();
    if (m == 0) {
        float sq = 0.f;
#pragma unroll
        for (int d = 0; d < 4; ++d)
#pragma unroll
            for (int r4 = 0; r4 < 4; ++r4) { const f32x4 c4 = *(const LAS f32x4*)(cmb + ((d * 4 + r4) * 64 + lane) * 4);
#pragma unroll
                for (int i = 0; i < 4; ++i) { const float y = oT[d][4 * r4 + i] * inv - lam * c4[i]; oT[d][4 * r4 + i] = y; sq += y * y; } }
        { auto rr = __builtin_amdgcn_permlane32_swap(__float_as_uint(sq), __float_as_uint(sq), false, false); sq = __uint_as_float(rr[0]) + __uint_as_float(rr[1]); }
        const float rn = __builtin_amdgcn_rsqf(sq * (1.0f / 128.0f) + 1e-6f) * (1.0f - LAM_INIT);
        bf16* yp = YB + (tok0 + qrow) * 1024 + h * 128;
#pragma unroll
        for (int d = 0; d < 4; ++d)
#pragma unroll
            for (int k = 0; k < 2; ++k) { u32x2 oa, ob;
                { const int g4 = 2 * k, d0 = 32 * d + 8 * g4 + 4 * h8; const f32x4 sg = *(const f32x4*)(subln + d0);
                  oa.x = pk2(oT[d][4 * g4 + 0] * rn * sg[0], oT[d][4 * g4 + 1] * rn * sg[1]); oa.y = pk2(oT[d][4 * g4 + 2] * rn * sg[2], oT[d][4 * g4 + 3] * rn * sg[3]); }
                { const int g4 = 2 * k + 1, d0 = 32 * d + 8 * g4 + 4 * h8; const f32x4 sg = *(const f32x4*)(subln + d0);
                  ob.x = pk2(oT[d][4 * g4 + 0] * rn * sg[0], oT[d][4 * g4 + 1] * rn * sg[1]); ob.y = pk2(oT[d][4 * g4 + 2] * rn * sg[2], oT[d][4 * g4 + 3] * rn * sg[3]); }
                const auto r0 = __builtin_amdgcn_permlane32_swap(oa.x, ob.x, false, false), r1 = __builtin_amdgcn_permlane32_swap(oa.y, ob.y, false, false);
                u32x4 w; w.x = r0[0]; w.y = r1[0]; w.z = r0[1]; w.w = r1[1];
                if (STORE) *(u32x4*)(yp + 32 * d + 16 * k + 8 * h8) = w; else if (w.x == 0x12345678u && w.y == 0x9abcdef0u) *(u32x4*)(yp + 32 * d + 16 * k + 8 * h8) = w; }
    }
    __syncthreads();
}

__global__ void __launch_bounds__(NWAVES * 64, 2) mega_fwd(Args args) {
    extern __shared__ __attribute__((aligned(16))) unsigned char lds_raw[];
    LAS unsigned char* lds = (LAS unsigned char*)lds_raw;
    const int tid = threadIdx.x, lane = tid & 63, wave = __builtin_amdgcn_readfirstlane(tid >> 6);
    const int G = gridDim.x, bx = blockIdx.x; const int vcu = (G % 8 == 0) ? (bx % 8) * (G / 8) + bx / 8 : bx;
    unsigned char* ws = args.ws;
    { LAS unsigned* misc0 = (LAS unsigned*)(lds + 131072); if (tid < 64) misc0[tid] = 0u; }
    __syncthreads();
    const XcdBarrier gbar = xcd_barrier_post((unsigned*)(ws + WS_CTL), (volatile LAS unsigned*)(lds + 131072) + 8);
    const float* x = args.in[0]; const int* positions = (const int*)args.in[1];
    const float *ffn1_norm = args.in[2], *ffn1_wg = args.in[3], *ffn1_wu = args.in[4], *ffn1_wd = args.in[5], *mix_norm = args.in[6], *w_in = args.in[7];
    const float *a_ln_g = args.in[8], *a_ln_b = args.in[9], *a_w_s = args.in[10], *a_b_s = args.in[11], *a_w_proj = args.in[12];
    const float *b_qn = args.in[13], *b_kn = args.in[14], *lq1 = args.in[15], *lk1 = args.in[16], *lq2 = args.in[17], *lk2 = args.in[18], *b_subln = args.in[19], *b_w_proj = args.in[20];
    const float *w_out = args.in[21], *ffn2_norm = args.in[22], *ffn2_wg = args.in[23], *ffn2_wu = args.in[24], *ffn2_wd = args.in[25];
    float* out = args.out;
    bf16 *W1GU = (bf16*)(ws + WS_W1GU), *W1D = (bf16*)(ws + WS_W1D), *WIN = (bf16*)(ws + WS_WIN), *WPA = (bf16*)(ws + WS_WPA), *WPB = (bf16*)(ws + WS_WPB), *WO = (bf16*)(ws + WS_WO);
    bf16 *W2GU = (bf16*)(ws + WS_W2GU), *W2D = (bf16*)(ws + WS_W2D), *WSP = (bf16*)(ws + WS_WSP);
    float *ROPE = (float*)(ws + WS_ROPE), *SS = (float*)(ws + WS_SS);
    bf16 *XB = (bf16*)(ws + WS_XB), *YA = (bf16*)(ws + WS_YA), *H = (bf16*)(ws + WS_H), *SG = (bf16*)(ws + WS_SG), *UV = (bf16*)(ws + WS_UV), *MM = (bf16*)(ws + WS_MM);
    bf16 *QB = (bf16*)(ws + WS_Q), *YB = (bf16*)(ws + WS_YB), *KB = (bf16*)(ws + WS_K), *VB = (bf16*)(ws + WS_V);

    for (int rep = 0; rep < NREP(0); ++rep) {
        LAS float* scr = (LAS float*)(lds + wave * 16384);
        const int gw = vcu * NWAVES + wave, NGW = G * NWAVES;
        constexpr int I_GU = 176 * 16, I_D = 32 * 44, I_IN = 192 * 16, I_PA = 32 * 8, I_PB = 32 * 16, I_WO = 32 * 16;
        constexpr int NITEMS = 2 * I_GU + 2 * I_D + I_IN + I_PA + I_PB + I_WO;
        for (int it = gw; it < NITEMS; it += NGW) {
            int r = it;
            if (r < I_GU) { conv_gu(ffn1_wg, ffn1_wu, ffn1_norm, W1GU, scr, r, lane); continue; } r -= I_GU;
            if (r < I_GU) { conv_gu(ffn2_wg, ffn2_wu, ffn2_norm, W2GU, scr, r, lane); continue; } r -= I_GU;
            if (r < I_IN) { conv_win(w_in, mix_norm, WIN, scr, r, lane); continue; } r -= I_IN;
            if (r < I_D) { conv_item(ffn1_wd, DM, DFF, 32 * (r / 44), W1D, 32 * (r / 44), false, nullptr, scr, r % 44, lane); continue; } r -= I_D;
            if (r < I_D) { conv_item(ffn2_wd, DM, DFF, 32 * (r / 44), W2D, 32 * (r / 44), false, nullptr, scr, r % 44, lane); continue; } r -= I_D;
            if (r < I_PA) { conv_item(a_w_proj, DM, AW, 32 * (r >> 3), WPA, 32 * (r >> 3), false, nullptr, scr, r & 7, lane); continue; } r -= I_PA;
            if (r < I_PB) { conv_item(b_w_proj, DM, DM, 32 * (r >> 4), WPB, 32 * (r >> 4), false, nullptr, scr, r & 15, lane); continue; } r -= I_PB;
            conv_item(w_out, DM, DM, 32 * (r >> 4), WO, 32 * (r >> 4), false, nullptr, scr, r & 15, lane);
        }
        const int gt = vcu * (NWAVES * 64) + tid, NGT = G * NWAVES * 64;
        for (int i = gt; i < 8 * 128 * 128; i += NGT) { const int s = i & 127, t = (i >> 7) & 127; WSP[i] = (bf16)f2bf(s <= t ? a_w_s[i] : 0.f); }
        for (int i = gt; i < MT * 8; i += NGT) { const int row = i >> 3, j = i & 7;
            const float inv = (j == 0) ? 1.0f : exp2f(-(float)j * 0.125f * 18.931568569324174f);
            const float ang = (float)positions[row] * inv;
            ROPE[(size_t)row * 16 + j] = cosf(ang); ROPE[(size_t)row * 16 + 8 + j] = sinf(ang); }
        for (int row0 = gw; row0 < MT; row0 += 4 * NGW) {
            f32x4 v[4][4];
#pragma unroll
            for (int q = 0; q < 4; ++q) { const int row = row0 + q * NGW; const f32x4* xr = (const f32x4*)(x + (size_t)(row < MT ? row : row0) * DM) + lane;
#pragma unroll
                for (int j = 0; j < 4; ++j) v[q][j] = __builtin_nontemporal_load(xr + 64 * j); }
#pragma unroll
            for (int q = 0; q < 4; ++q) { const int row = row0 + q * NGW; if (row >= MT) break; float sq = 0.f;
                unsigned long long* o8 = (unsigned long long*)(XB + (size_t)row * DM) + lane;
#pragma unroll
                for (int j = 0; j < 4; ++j) { const f32x4 t = v[q][j]; sq += (t[0] * t[0] + t[1] * t[1]) + (t[2] * t[2] + t[3] * t[3]);
                    o8[64 * j] = (unsigned long long)pk2(t[0], t[1]) | ((unsigned long long)pk2(t[2], t[3]) << 32); }
                sq = wave_sum(sq);
                if (lane < 16) SS[(size_t)row * 16 + lane] = (lane == 0) ? sq : 0.f; }
        }
    }
    xcd_barrier(gbar);
    if (REP_MASK & 256) { for (int i = 0; i < 8; ++i) xcd_barrier(gbar); }
    if (REP_MASK & 512) { pg8::Gemm g{XB, W1GU, MT, 2 * DFF, DM}; pg8::StaticOrder S; S.init(MT, 2 * DFF, G, bx);
      pg8::EpiPlainH E{H, DFF};
      pg8::gemm_phase<pg8::EpiPlainH, pg8::StaticOrder, true, true>(lds, g, S, E); xcd_barrier(gbar); }
    for (int rep = 0; rep < NREP(1); ++rep) { if (rep) xcd_barrier(gbar); pg8::Gemm g{XB, W1GU, MT, 2 * DFF, DM}; pg8::StaticOrder S; S.init(MT, 2 * DFF, G, bx);
      pg8::rs_tags_clear(lds); pg8::EpiSwiglu E{H, SS, DFF, lds};
      pg8::gemm_phase<pg8::EpiSwiglu, pg8::StaticOrder, true, true>(lds, g, S, E); }
    xcd_barrier(gbar);
    for (int rep = 0; rep < NREP(2); ++rep) { if (rep) xcd_barrier(gbar); pg8::Gemm g{H, W1D, MT, DM, DFF}; pg8::StaticOrder S; S.init(MT, DM, G, bx);
      pg8::EpiResid<true> E{x, out, XB, SS, 0.5f};
      pg8::gemm_phase<pg8::EpiResid<true>, pg8::StaticOrder, true, true>(lds, g, S, E); }
    xcd_barrier(gbar);
    for (int rep = 0; rep < NREP(3); ++rep) { if (rep) xcd_barrier(gbar); pg8::Gemm g{XB, WIN, MT, INC, DM}; pg8::StaticOrder S; S.init(MT, INC, G, bx);
      pg8::rs_tags_clear(lds); pg8::EpiWin E{SS, SG, UV, QB, KB, VB, ROPE, b_qn, b_kn, QSCALE, lds};
      pg8::gemm_phase<pg8::EpiWin, pg8::StaticOrder, true, true>(lds, g, S, E); }
    xcd_barrier(gbar);
    {
        for (int rep = 0; rep < NREP(5); ++rep) for (int c = vcu; c < MT / 128; c += G) gmlp_unit(c, UV, WSP, a_ln_g, a_ln_b, a_b_s, YA, lds);
        float d1 = lq1[lane] * lk1[lane], d2 = lq2[lane] * lk2[lane];
        d1 = wave_sum(d1); d2 = wave_sum(d2);
        const float lam = expf(d1) - expf(d2) + LAM_INIT;
        for (int slot = vcu; slot < BATCH * NH * 4; slot += G) { const int bh = slot >> 2, sub = slot & 3;
            for (int rep = 0; rep < NREP(4); ++rep)
            for (int r = 0; r < 8; ++r) { const int rp = (r & 1) ? (r >> 1) : 7 - (r >> 1); const int qb = 4 * rp + ((sub + r) & 3);
                if (rep + 1 < NREP(4)) attn_unit<false, ATT_VAR>(bh >> 3, bh & 7, qb, QB, KB, VB, YB, lds, lam, b_subln);
                else attn_unit<true>(bh >> 3, bh & 7, qb, QB, KB, VB, YB, lds, lam, b_subln); } }
    }
    xcd_barrier(gbar);
    { pg8::Gemm g{YA, WPA, MT, DM, AW}; pg8::StaticOrder S; S.init(MT, DM, G, bx);
      pg8::EpiGate<true> E{SG, 0, MM};
      pg8::gemm_phase<pg8::EpiGate<true>, pg8::StaticOrder, true, true>(lds, g, S, E); }
    __syncthreads();
    { pg8::Gemm g{YB, WPB, MT, DM, DM}; pg8::StaticOrder S; S.init(MT, DM, G, bx);
      pg8::EpiGate<false> E{SG, 1024, MM};
      pg8::gemm_phase<pg8::EpiGate<false>, pg8::StaticOrder, true, true>(lds, g, S, E); }
    xcd_barrier(gbar);
    { pg8::Gemm g{MM, WO, MT, DM, DM}; pg8::StaticOrder S; S.init(MT, DM, G, bx);
      pg8::EpiResid<true> E{out, out, XB, SS, 1.0f};
      pg8::gemm_phase<pg8::EpiResid<true>, pg8::StaticOrder, true, true>(lds, g, S, E); }
    xcd_barrier(gbar);
    for (int rep = 0; rep < NREP(7); ++rep) { if (rep) xcd_barrier(gbar); pg8::Gemm g{XB, W2GU, MT, 2 * DFF, DM}; pg8::StaticOrder S; S.init(MT, 2 * DFF, G, bx);
      pg8::rs_tags_clear(lds); pg8::EpiSwiglu E{H, SS, DFF, lds};
      pg8::gemm_phase<pg8::EpiSwiglu, pg8::StaticOrder, true, true>(lds, g, S, E); }
    xcd_barrier(gbar);
    { pg8::Gemm g{H, W2D, MT, DM, DFF}; pg8::StaticOrder S; S.init(MT, DM, G, bx);
      pg8::EpiResid<false> E{out, out, nullptr, nullptr, 0.5f};
      pg8::gemm_phase<pg8::EpiResid<false>, pg8::StaticOrder, true, true>(lds, g, S, E); }
}

extern "C" void kernel_launch(void* const* d_in, const int* in_sizes, int n_in, void* d_out, int out_size, void* d_ws, size_t ws_size, hipStream_t stream) {
    static int grid = 0;
    if (grid == 0) {
        if (n_in != 26 || in_sizes[0] != MT * DM || out_size != MT * DM || ws_size < WS_END) { fprintf(stderr, "kernel_launch: unexpected shapes (n_in %d, in0 %d, out %d, ws %zu); nothing launched\n", n_in, n_in > 0 ? in_sizes[0] : -1, out_size, ws_size); grid = -1; return; }
        int dev = 0, cus = 0, per_cu = 0;
        if (hipGetDevice(&dev) != hipSuccess || hipDeviceGetAttribute(&cus, hipDeviceAttributeMultiprocessorCount, dev) != hipSuccess) { grid = -1; return; }
        if (hipFuncSetAttribute((const void*)mega_fwd, hipFuncAttributeMaxDynamicSharedMemorySize, LDS_BYTES) != hipSuccess) { fprintf(stderr, "kernel_launch: hipFuncSetAttribute failed\n"); grid = -1; return; }
        if (hipOccupancyMaxActiveBlocksPerMultiprocessor(&per_cu, (const void*)mega_fwd, NWAVES * 64, LDS_BYTES) != hipSuccess || per_cu < 1) { fprintf(stderr, "kernel_launch: occupancy query says %d blocks per CU\n", per_cu); (void)hipGetLastError(); grid = -1; return; }
        grid = cus;
    }
    if (grid < 0) return;
    if (hipMemsetAsync((char*)d_ws + WS_CTL, 0, CTL_ZERO_BYTES, stream) != hipSuccess) { fprintf(stderr, "kernel_launch: memset of the barrier words failed\n"); return; }
    Args a{};
    for (int i = 0; i < 26; ++i) a.in[i] = (const float*)d_in[i];
    a.out = (float*)d_out; a.ws = (unsigned char*)d_ws;
    void* kargs[] = {&a};
    hipError_t e = hipLaunchCooperativeKernel((const void*)mega_fwd, dim3(grid), dim3(NWAVES * 64), kargs, LDS_BYTES, stream);
    if (e != hipSuccess) fprintf(stderr, "kernel_launch: cooperative launch failed: %s (grid %d)\n", hipGetErrorString(e), grid);
}
```
